# Optimizing an MI355X kernel written in HIP

```python
import jax, jax.numpy as jnp
from jax import lax
import numpy as np

D_MODEL = 1024
BATCH = 1
SEQ = 16384
DEPTH = 4

CHUNK = 64
MEM_LEN = 256
N_A_LAYERS = DEPTH // 2
N_B_LAYERS = DEPTH - N_A_LAYERS
MEM_HEADS = 4
MEM_HEAD_DIM = 64
MEM_W = MEM_HEADS * MEM_HEAD_DIM
MAIN_W = D_MODEL - MEM_W
CONV_W = MAIN_W
CONV_K = 3
DIFF_HEAD_DIM = 64
DIFF_HEADS = MAIN_W // (2 * DIFF_HEAD_DIM)
DIFF_QK = DIFF_HEADS * DIFF_HEAD_DIM
ROPE_DIM = DIFF_HEAD_DIM // 4
ROPE_THETA = 500000.0
D_FF = 4 * D_MODEL
Q_BLOCK = 128
EPS = 1e-6
SUBLN_EPS = 1e-5

kernel_name = "yoco_shortconv_diffattn_memory_trunk"


def rmsnorm(x, g, eps=EPS):
    xf = x.astype(jnp.float32)
    y = xf * lax.rsqrt(jnp.mean(xf * xf, axis=-1, keepdims=True) + eps)
    return (y * g.astype(jnp.float32)).astype(x.dtype)


def rope_tables(seq):
    inv = 1.0 / (ROPE_THETA ** (jnp.arange(0, ROPE_DIM, 2, dtype=jnp.float32) / ROPE_DIM))
    ang = jnp.arange(seq, dtype=jnp.float32)[:, None] * inv[None, :]
    return jnp.cos(ang), jnp.sin(ang)


def partial_rope(x, cos, sin):
    half = ROPE_DIM // 2
    c = cos[None, :, None, :].astype(x.dtype)
    s = sin[None, :, None, :].astype(x.dtype)
    x1, x2, xp = x[..., :half], x[..., half:ROPE_DIM], x[..., ROPE_DIM:]
    return jnp.concatenate([x1 * c - x2 * s, x1 * s + x2 * c, xp], axis=-1)


def short_conv_mixer(h, gate_b, gate_c, w_conv):
    u = gate_c * h
    s_len = u.shape[1]
    up = jnp.pad(u, ((0, 0), (CONV_K - 1, 0), (0, 0)))
    y = w_conv[0] * up[:, 0:s_len]
    for k in range(1, CONV_K):
        y = y + w_conv[k] * up[:, k:k + s_len]
    return gate_b * y


def memory_attention(q, mem_n, w_mem_kv, q_gain, k_gain):
    b, s, _ = q.shape
    m = mem_n.shape[1]
    kv = jnp.einsum('bmd,de->bme', mem_n, w_mem_kv)
    k = kv[..., :MEM_W].reshape(b, m, MEM_HEADS, MEM_HEAD_DIM)
    v = kv[..., MEM_W:].reshape(b, m, MEM_HEADS, MEM_HEAD_DIM)
    qh = rmsnorm(q.reshape(b, s, MEM_HEADS, MEM_HEAD_DIM), q_gain)
    k = rmsnorm(k, k_gain)
    sc = jnp.einsum('bshd,bmhd->bhsm', qh, k).astype(jnp.float32) * (MEM_HEAD_DIM ** -0.5)
    p = jax.nn.softmax(sc, axis=-1).astype(v.dtype)
    o = jnp.einsum('bhsm,bmhd->bshd', p, v)
    return o.reshape(b, s, MEM_W)


def diff_attention(q1, q2, k1, k2, v, lam):
    b, s, h, dh = q1.shape
    nblk = s // Q_BLOCK
    scale = dh ** -0.5
    key_chunk = jnp.arange(s) // CHUNK
    qb1 = jnp.moveaxis(q1.reshape(b, nblk, Q_BLOCK, h, dh), 1, 0)
    qb2 = jnp.moveaxis(q2.reshape(b, nblk, Q_BLOCK, h, dh), 1, 0)

    def one_block(args):
        a1, a2, i = args
        q_chunk = (i * Q_BLOCK + jnp.arange(Q_BLOCK)) // CHUNK
        mask = (key_chunk[None, :] <= q_chunk[:, None])[None, None]
        s1 = jnp.einsum('bqhd,bkhd->bhqk', a1, k1).astype(jnp.float32) * scale
        s2 = jnp.einsum('bqhd,bkhd->bhqk', a2, k2).astype(jnp.float32) * scale
        p1 = jax.nn.softmax(jnp.where(mask, s1, -jnp.inf), axis=-1)
        p2 = jax.nn.softmax(jnp.where(mask, s2, -jnp.inf), axis=-1)
        p = (p1 - lam * p2).astype(v.dtype)
        return jnp.einsum('bhqk,bkhe->bqhe', p, v)

    out = lax.map(one_block, (qb1, qb2, jnp.arange(nblk)))
    return jnp.moveaxis(out, 0, 1).reshape(b, s, h, 2 * dh)


def sqrelu_mlp(h, w_up, w_down):
    u = jnp.einsum('bsd,df->bsf', h, w_up)
    return jnp.einsum('bsf,fd->bsd', jnp.square(jax.nn.relu(u)), w_down)


def setup_inputs(seed: int = 0) -> dict:
    key = jax.random.key(seed)
    ks = jax.random.split(key, 24)
    f32 = jnp.float32
    nrm = lambda k, shp, sc: jax.random.normal(k, shp, f32) * sc
    gain = lambda k, shp: 1.0 + 0.02 * jax.random.normal(k, shp, f32)
    return {
        "x": nrm(ks[0], (BATCH, SEQ, D_MODEL), 1.0),
        "mem": nrm(ks[1], (BATCH, MEM_LEN, D_MODEL), 1.0),
        "norm_mix": gain(ks[2], (DEPTH, D_MODEL)),
        "norm_mlp": gain(ks[3], (DEPTH, D_MODEL)),
        "a_w_in": nrm(ks[4], (N_A_LAYERS, D_MODEL, 3 * CONV_W + MEM_W), D_MODEL ** -0.5),
        "a_conv": nrm(ks[5], (N_A_LAYERS, CONV_K, CONV_W), CONV_K ** -0.5),
        "b_w_q": nrm(ks[6], (N_B_LAYERS, D_MODEL, 2 * DIFF_QK + MEM_W), D_MODEL ** -0.5),
        "b_q_norm": gain(ks[7], (N_B_LAYERS, DIFF_HEAD_DIM)),
        "b_lam": nrm(ks[8], (N_B_LAYERS, 4, DIFF_HEAD_DIM), 0.1),
        "b_subln": gain(ks[9], (N_B_LAYERS, 2 * DIFF_HEAD_DIM)),
        "kv_norm": gain(ks[10], (D_MODEL,)),
        "w_kv": nrm(ks[11], (D_MODEL, 2 * DIFF_QK + MAIN_W), D_MODEL ** -0.5),
        "k_norm": gain(ks[12], (DIFF_HEAD_DIM,)),
        "mem_norm": gain(ks[13], (D_MODEL,)),
        "w_mem_kv": nrm(ks[14], (DEPTH, D_MODEL, 2 * MEM_W), D_MODEL ** -0.5),
        "mem_q_norm": gain(ks[15], (DEPTH, MEM_HEAD_DIM)),
        "mem_k_norm": gain(ks[16], (DEPTH, MEM_HEAD_DIM)),
        "w_o": nrm(ks[17], (DEPTH, MAIN_W + MEM_W, D_MODEL), (MAIN_W + MEM_W) ** -0.5),
        "w_up": nrm(ks[18], (DEPTH, D_MODEL, D_FF), D_MODEL ** -0.5),
        "w_down": nrm(ks[19], (DEPTH, D_FF, D_MODEL), 0.5 * D_FF ** -0.5),
    }


def reference(x, mem, norm_mix, norm_mlp, a_w_in, a_conv, b_w_q, b_q_norm, b_lam, b_subln,
              kv_norm, w_kv, k_norm, mem_norm, w_mem_kv, mem_q_norm, mem_k_norm,
              w_o, w_up, w_down):
    b, s, _ = x.shape
    cos, sin = rope_tables(s)
    mem_n = rmsnorm(mem, mem_norm)
    k1 = k2 = v = None
    for l in range(DEPTH):
        h = rmsnorm(x, norm_mix[l])
        if l < N_A_LAYERS:
            proj = jnp.einsum('bsd,de->bse', h, a_w_in[l])
            gate_b = proj[..., :CONV_W]
            gate_c = proj[..., CONV_W:2 * CONV_W]
            hv = proj[..., 2 * CONV_W:3 * CONV_W]
            qm = proj[..., 3 * CONV_W:]
            main = short_conv_mixer(hv, gate_b, gate_c, a_conv[l])
        else:
            j = l - N_A_LAYERS
            proj = jnp.einsum('bsd,de->bse', h, b_w_q[j])
            q1 = proj[..., :DIFF_QK].reshape(b, s, DIFF_HEADS, DIFF_HEAD_DIM)
            q2 = proj[..., DIFF_QK:2 * DIFF_QK].reshape(b, s, DIFF_HEADS, DIFF_HEAD_DIM)
            qm = proj[..., 2 * DIFF_QK:]
            q1 = partial_rope(rmsnorm(q1, b_q_norm[j]), cos, sin)
            q2 = partial_rope(rmsnorm(q2, b_q_norm[j]), cos, sin)
            lam_init = 0.8 - 0.6 * float(np.exp(-0.3 * l))
            lp = b_lam[j].astype(jnp.float32)
            lam = (jnp.exp(jnp.sum(lp[0] * lp[1])) - jnp.exp(jnp.sum(lp[2] * lp[3]))
                   + lam_init)
            o = diff_attention(q1, q2, k1, k2, v, lam)
            o = rmsnorm(o, b_subln[j], SUBLN_EPS) * (1.0 - lam_init)
            main = o.reshape(b, s, MAIN_W)
        mo = memory_attention(qm, mem_n, w_mem_kv[l], mem_q_norm[l], mem_k_norm[l])
        x = x + jnp.einsum('bse,ed->bsd', jnp.concatenate([main, mo], axis=-1), w_o[l])
        x = x + sqrelu_mlp(rmsnorm(x, norm_mlp[l]), w_up[l], w_down[l])
        if l == N_A_LAYERS - 1:
            kvh = rmsnorm(x, kv_norm)
            kv = jnp.einsum('bsd,de->bse', kvh, w_kv)
            k1 = kv[..., :DIFF_QK].reshape(b, s, DIFF_HEADS, DIFF_HEAD_DIM)
            k2 = kv[..., DIFF_QK:2 * DIFF_QK].reshape(b, s, DIFF_HEADS, DIFF_HEAD_DIM)
            v = kv[..., 2 * DIFF_QK:].reshape(b, s, DIFF_HEADS, 2 * DIFF_HEAD_DIM)
            k1 = partial_rope(rmsnorm(k1, k_norm), cos, sin)
            k2 = partial_rope(rmsnorm(k2, k_norm), cos, sin)
    return x
```

```cpp
#include <hip/hip_runtime.h>
#include <hip/hip_cooperative_groups.h>
#include <cstdio>
#include <cstdint>
namespace cg = cooperative_groups;
namespace pg8 {
#define PG8_LAS __attribute__((address_space(3)))
typedef unsigned short bf16_t;
typedef short bf16x8 __attribute__((ext_vector_type(8)));
typedef float f32x4 __attribute__((ext_vector_type(4)));
typedef unsigned u32x4 __attribute__((ext_vector_type(4)));
constexpr int BM = 256, BK = 64, HALF = 128, HTB = HALF * BK * 2  , STAGE_BYTES = 8 * HTB, NXCD = 8, WGM = 8;

__host__ __device__ __forceinline__ int lds_byte(int r, int c) { const int st = (r >> 4) * 2 + (c >> 5), rr = r & 15, cc = c & 31, ob = rr * 64 + cc * 2; return st * 1024 + (ob ^ (((ob >> 9) & 1) << 5)); }
__host__ __device__ __forceinline__ void stage_rc(int b, int& R, int& C) { const int st = b / 1024, sb = b % 1024, swz = sb ^ (((sb >> 9) & 1) << 5); R = (st >> 1) * 16 + swz / 64; C = (st & 1) * 32 + (swz % 64) / 2; }
__host__ __device__ __forceinline__ int perm32(int rho) { const int n = rho >> 4, i = rho & 15; return 8 * (i >> 2) + 4 * n + (i & 3); }

struct Unit { int pm, pn; };
struct Gemm { const bf16_t* A; const bf16_t* Bt; int M, N, K; };

struct StaticOrder {
    int nM, nN, nwg, G, c;
    __host__ __device__ void init(int M, int N, int G_, int c_) { nM = M / BM; nN = N / BM; nwg = nM * nN; G = G_; c = c_; }
    __host__ __device__ bool next(int i, Unit& u) const {
        const long L = (long)i * G + c; if (L >= nwg) return false;
        int wgid = (int)L; { const int q = nwg / NXCD, r = nwg % NXCD, xcd = wgid % NXCD, off = wgid / NXCD; wgid = (xcd < r ? xcd * (q + 1) : r * (q + 1) + (xcd - r) * q) + off; }
        const int nig = WGM * nN, gid = wgid / nig, fm = gid * WGM, gsz = (nM - fm) < WGM ? (nM - fm) : WGM;
        u.pm = fm + ((wgid % nig) % gsz); u.pn = (wgid % nig) / gsz; return true;
    }
    __device__ __forceinline__ void a_ready(const Unit&) const {}
    __device__ __forceinline__ void done(const Unit&) const {}
};

typedef float f32x2_cv __attribute__((ext_vector_type(2))); typedef __bf16 bf16x2_cv __attribute__((ext_vector_type(2)));
__device__ __forceinline__ unsigned cvt_pk_bf16(float lo, float hi) { f32x2_cv v = {lo, hi}; bf16x2_cv b = __builtin_convertvector(v, bf16x2_cv); return __builtin_bit_cast(unsigned, b); }
template <class Epi, class Sched, bool ALIGN_EPI = false, bool SP2 = false>
__device__ __forceinline__ void gemm_phase(PG8_LAS unsigned char* lds, const Gemm g, const Sched& S, const Epi& E) {
    int tid_ = threadIdx.x; asm volatile("" : "+v"(tid_));
    const int tid = tid_, wid = __builtin_amdgcn_readfirstlane(tid >> 6), lane = tid & 63, wr = wid >> 2, wc = wid & 3, fr = lane & 15, fq = lane >> 4;
    const int K = g.K, nt = K / BK;
    unsigned voffA[2], voffB[2];
#pragma unroll
    for (int i = 0; i < 2; ++i) { int R, C; stage_rc(tid * 16 + i * 8192, R, C); const int Rb = Epi::PERM ? ((R & ~31) + perm32(R & 31)) : R;
        voffA[i] = (unsigned)(R * K + C) * 2u; voffB[i] = (unsigned)(Rb * K + C) * 2u; }
    const size_t kstep = (size_t)(BK * 2);
    const size_t hstep = (size_t)HALF * K * 2;
    const size_t tstep = 2 * hstep;
    const unsigned ldsw = (unsigned)wid * 1024u;
    const int aoff = lds_byte(wr * 64 + fr, fq * 8), boff = lds_byte(wc * 32 + fr, fq * 8);
#define PG8_SA(b, h) (((b) * 2 + (h)) * HTB)
#define PG8_SB(b, h) ((4 + (b) * 2 + (h)) * HTB)
#define PG8_STAGE(bufoff, gbase, voff) do { _Pragma("unroll") for (int _i = 0; _i < 2; ++_i) \
        __builtin_amdgcn_global_load_lds((const unsigned*)((const char*)(gbase) + (voff)[_i]), (PG8_LAS unsigned*)(lds + (bufoff) + ldsw + _i * 8192), 16, 0, 0); } while (0)
#define PG8_LDA(dst, b, h) do { _Pragma("unroll") for (int m = 0; m < 4; ++m) _Pragma("unroll") for (int k = 0; k < 2; ++k) dst[m][k] = *(const PG8_LAS bf16x8*)(lds + PG8_SA(b, h) + aoff + m * 2048 + k * 1024); } while (0)
#define PG8_LDB(dst, b, h) do { _Pragma("unroll") for (int n = 0; n < 2; ++n) _Pragma("unroll") for (int k = 0; k < 2; ++k) dst[n][k] = *(const PG8_LAS bf16x8*)(lds + PG8_SB(b, h) + boff + n * 2048 + k * 1024); } while (0)
#define PG8_MMA(ai, bj, At, Bt) do { __builtin_amdgcn_s_setprio(1); _Pragma("unroll") for (int m = 0; m < 4; ++m) _Pragma("unroll") for (int n = 0; n < 2; ++n) _Pragma("unroll") for (int k = 0; k < 2; ++k) \
        acc[ai][bj][m][n] = __builtin_amdgcn_mfma_f32_16x16x32_bf16(Bt[n][k], At[m][k], acc[ai][bj][m][n], 0, 0, 0); __builtin_amdgcn_s_setprio(0); } while (0)
#define PG8_WAIT_V(n) asm volatile("s_waitcnt vmcnt(" #n ")" ::: "memory")
#define PG8_WAIT_L(n) asm volatile("s_waitcnt lgkmcnt(" #n ")" ::: "memory")
#define PG8_BAR __builtin_amdgcn_s_barrier()
#define PG8_SCHED __builtin_amdgcn_sched_barrier(0)
    Unit cur, nxt; int ui = 0;
    if (!S.next(0, cur)) return;
    f32x4 acc[2][2][4][2];
#pragma unroll
    for (int a = 0; a < 2; ++a)
#pragma unroll
        for (int b = 0; b < 2; ++b)
#pragma unroll
            for (int m = 0; m < 4; ++m)
#pragma unroll
                for (int n = 0; n < 2; ++n) acc[a][b][m][n] = (f32x4){0.f, 0.f, 0.f, 0.f};
    bf16x8 At[4][2], B0[2][2], B1[2][2];
    const char* cA = (const char*)g.A + (size_t)cur.pm * tstep; const char* cB = (const char*)g.Bt + (size_t)cur.pn * tstep;
    S.a_ready(cur);
    if constexpr (SP2) {
        PG8_STAGE(PG8_SB(0, 0), cB, voffB); PG8_STAGE(PG8_SB(0, 1), cB + hstep, voffB); PG8_STAGE(PG8_SA(0, 0), cA, voffA); PG8_STAGE(PG8_SA(0, 1), cA + hstep, voffA);
        if (wr == 1) PG8_BAR;
        PG8_WAIT_V(2); PG8_BAR;
        PG8_STAGE(PG8_SB(1, 0), cB + kstep, voffB); PG8_STAGE(PG8_SA(1, 0), cA + kstep, voffA); PG8_STAGE(PG8_SB(1, 1), cB + hstep + kstep, voffB);
        PG8_WAIT_V(6); PG8_BAR;
    } else {
        PG8_STAGE(PG8_SB(0, 0), cB, voffB); PG8_STAGE(PG8_SA(0, 0), cA, voffA); PG8_STAGE(PG8_SB(0, 1), cB + hstep, voffB); PG8_STAGE(PG8_SA(0, 1), cA + hstep, voffA);
        if (wr == 1) PG8_BAR;
        PG8_WAIT_V(4); PG8_BAR;
        PG8_STAGE(PG8_SB(1, 0), cB + kstep, voffB); PG8_STAGE(PG8_SA(1, 0), cA + kstep, voffA); PG8_STAGE(PG8_SB(1, 1), cB + hstep + kstep, voffB);
        PG8_WAIT_V(6); PG8_BAR;
    }
    for (;;) {
        const bool has_next = S.next(ui + 1, nxt);
        const char* nA = has_next ? (const char*)g.A + (size_t)nxt.pm * tstep : cA; const char* nB = has_next ? (const char*)g.Bt + (size_t)nxt.pn * tstep : cB;
        for (int t = 0; t < nt; t += 2) {
            const bool last = (t == nt - 2);
            const char* a1 = cA + (size_t)(t + 1) * kstep;
            const char* a2 = last ? nA : cA + (size_t)(t + 2) * kstep; const char* b2 = last ? nB : cB + (size_t)(t + 2) * kstep;
            const char* a3 = a2 + kstep; const char* b3 = b2 + kstep;
            if (last && has_next) S.a_ready(nxt);
            if constexpr (SP2) {
            PG8_LDB(B0, 0, 0); PG8_LDB(B1, 0, 1); PG8_SCHED; PG8_LDA(At, 0, 0); PG8_STAGE(PG8_SA(1, 1), a1 + hstep, voffA);
            PG8_WAIT_V(8); PG8_WAIT_L(0); PG8_BAR; PG8_MMA(0, 0, At, B0); PG8_MMA(0, 1, At, B1); PG8_BAR; PG8_SCHED;
            PG8_LDA(At, 0, 1); PG8_STAGE(PG8_SB(0, 0), b2, voffB); PG8_STAGE(PG8_SB(0, 1), b2 + hstep, voffB); PG8_STAGE(PG8_SA(0, 0), a2, voffA);
            PG8_WAIT_V(8); PG8_WAIT_L(0); PG8_BAR; PG8_MMA(1, 0, At, B0); PG8_MMA(1, 1, At, B1); PG8_BAR; PG8_SCHED;
            PG8_LDB(B0, 1, 0); PG8_LDB(B1, 1, 1); PG8_SCHED; PG8_LDA(At, 1, 0); PG8_STAGE(PG8_SA(0, 1), a2 + hstep, voffA);
            PG8_WAIT_V(8); PG8_WAIT_L(0); PG8_BAR; PG8_MMA(0, 0, At, B0); PG8_MMA(0, 1, At, B1); PG8_BAR; PG8_SCHED;
            PG8_LDA(At, 1, 1); PG8_STAGE(PG8_SB(1, 0), b3, voffB); PG8_STAGE(PG8_SB(1, 1), b3 + hstep, voffB); PG8_STAGE(PG8_SA(1, 0), a3, voffA);
            PG8_WAIT_V(8); PG8_WAIT_L(0); PG8_BAR; PG8_MMA(1, 0, At, B0); PG8_MMA(1, 1, At, B1); PG8_BAR; PG8_SCHED;
            } else {
            PG8_LDB(B0, 0, 0); PG8_SCHED; PG8_LDA(At, 0, 0); PG8_STAGE(PG8_SA(1, 1), a1 + hstep, voffA);
            PG8_WAIT_L(8); PG8_BAR; PG8_WAIT_L(0); PG8_MMA(0, 0, At, B0); PG8_BAR; PG8_SCHED;
            PG8_LDB(B1, 0, 1); PG8_STAGE(PG8_SB(0, 0), b2, voffB);
            PG8_BAR; PG8_WAIT_L(0); PG8_MMA(0, 1, At, B1); PG8_BAR;
            PG8_LDA(At, 0, 1); PG8_STAGE(PG8_SA(0, 0), a2, voffA);
            PG8_BAR; PG8_WAIT_L(0); PG8_MMA(1, 0, At, B0); PG8_BAR; PG8_SCHED;
            PG8_STAGE(PG8_SB(0, 1), b2 + hstep, voffB);
            PG8_WAIT_V(6); PG8_BAR; PG8_MMA(1, 1, At, B1); PG8_BAR;
            PG8_LDB(B0, 1, 0); PG8_SCHED; PG8_LDA(At, 1, 0); PG8_STAGE(PG8_SA(0, 1), a2 + hstep, voffA);
            PG8_WAIT_L(8); PG8_BAR; PG8_WAIT_L(0); PG8_MMA(0, 0, At, B0); PG8_BAR; PG8_SCHED;
            PG8_LDB(B1, 1, 1); PG8_STAGE(PG8_SB(1, 0), b3, voffB);
            PG8_BAR; PG8_WAIT_L(0); PG8_MMA(0, 1, At, B1); PG8_BAR;
            PG8_LDA(At, 1, 1); PG8_STAGE(PG8_SA(1, 0), a3, voffA);
            PG8_BAR; PG8_WAIT_L(0); PG8_MMA(1, 0, At, B0); PG8_BAR; PG8_SCHED;
            PG8_STAGE(PG8_SB(1, 1), b3 + hstep, voffB);
            PG8_WAIT_V(6); PG8_BAR; PG8_MMA(1, 1, At, B1); PG8_BAR;
            }
        }
        if constexpr (ALIGN_EPI) { if (wr == 0) PG8_BAR; }
        if constexpr (!Epi::AFTER_DRAIN) { E(acc, cur, wr, wc, fr, fq); S.done(cur); }
        if (!has_next) break;
#pragma unroll
        for (int a = 0; a < 2; ++a)
#pragma unroll
            for (int b = 0; b < 2; ++b)
#pragma unroll
                for (int m = 0; m < 4; ++m)
#pragma unroll
                    for (int n = 0; n < 2; ++n) acc[a][b][m][n] = (f32x4){0.f, 0.f, 0.f, 0.f};
        cur = nxt; cA = nA; cB = nB; ++ui;
        if constexpr (ALIGN_EPI) { if (wr == 1) PG8_BAR; }
    }
    PG8_WAIT_V(0);
    if constexpr (!ALIGN_EPI) { if (wr == 0) PG8_BAR; }
    PG8_BAR;
    if constexpr (Epi::AFTER_DRAIN) { E.fused(acc, cur, wr, wc, fr, fq, lds, wid, lane); S.done(cur); }
#undef PG8_SA
#undef PG8_SB
#undef PG8_STAGE
#undef PG8_LDA
#undef PG8_LDB
#undef PG8_MMA
#undef PG8_WAIT_V
#undef PG8_WAIT_L
#undef PG8_BAR
#undef PG8_SCHED
}
}

#define LAS __attribute__((address_space(3)))
typedef unsigned short bf16_t;
typedef short bf16x8 __attribute__((ext_vector_type(8)));
typedef float f32x4 __attribute__((ext_vector_type(4)));
typedef float f32x16 __attribute__((ext_vector_type(16)));
typedef unsigned u32x4 __attribute__((ext_vector_type(4)));
typedef unsigned u32x2 __attribute__((ext_vector_type(2)));

constexpr int S_ = 16384, D_ = 1024, FF_ = 4096, MEMLEN = 256;
constexpr int NWAVES = 8;
constexpr size_t MiB = 1u << 20;
constexpr size_t WS_STATS = 0;
constexpr size_t WS_MEMIMG = 1 * MiB;
constexpr size_t WS_WINA = 2 * MiB;
constexpr size_t WS_WQKV = 12 * MiB;
constexpr size_t WS_WQ1 = 17 * MiB;
constexpr size_t WS_WMKV = 19 * MiB;
constexpr size_t WS_WO = 23 * MiB;
constexpr size_t WS_WUP = 31 * MiB;
constexpr size_t WS_WDN = 39 * MiB;
constexpr size_t WS_XB = 47 * MiB;
constexpr size_t WS_KVIMG = 79 * MiB;
constexpr size_t WS_H = 127 * MiB;
constexpr size_t WS_U = WS_H;
constexpr size_t WS_QB = WS_H;
constexpr size_t WS_CAT = WS_H + 32 * MiB;
constexpr size_t WS_KVB = WS_H + 64 * MiB;
constexpr size_t WS_MEMN = WS_H + 112 * MiB;
constexpr size_t WS_MKV = WS_H + 113 * MiB;
constexpr size_t WS_CTL = 255 * MiB;
constexpr size_t WS_END = 256 * MiB;

constexpr int RING_BYTES = 131072;
constexpr int MISC_OFF = RING_BYTES;
constexpr int LDS_BYTES = 147456;

#define LDS_WAIT() asm volatile("s_waitcnt lgkmcnt(0)" ::: "memory")

struct Args {
    const float *x, *mem, *norm_mix, *norm_mlp, *a_w_in, *a_conv, *b_w_q, *b_q_norm, *b_lam, *b_subln, *kv_norm, *w_kv, *k_norm, *mem_norm,
        *w_mem_kv, *mem_q_norm, *mem_k_norm, *w_o, *w_up, *w_down;
    float* out; unsigned char* ws;
};

__device__ __forceinline__ float bf_lo(unsigned w) { return __uint_as_float(w << 16); }
__device__ __forceinline__ float bf_hi(unsigned w) { return __uint_as_float(w & 0xffff0000u); }
__device__ __forceinline__ float wave_sum(float v) {
#pragma unroll
    for (int o = 1; o < 64; o <<= 1) v += __shfl_xor(v, o);
    return v;
}
__device__ __forceinline__ void st16_wt(void* p, u32x4 v) { asm volatile("global_store_dwordx4 %0, %1, off sc1\n\ts_nop 1" :: "v"(p), "v"(v) : "memory"); }
__device__ __forceinline__ void st8_wt(void* p, u32x2 v) { asm volatile("global_store_dwordx2 %0, %1, off sc1\n\ts_nop 1" :: "v"(p), "v"(v) : "memory"); }
__device__ __forceinline__ float row_rstd(const float* stats, int row) {
    const f32x4* p = (const f32x4*)(stats + (size_t)row * 16);
    const f32x4 a = p[0], b = p[1], c = p[2], d = p[3];
    const float s = ((a[0] + a[1]) + (a[2] + a[3])) + ((b[0] + b[1]) + (b[2] + b[3])) + ((c[0] + c[1]) + (c[2] + c[3])) + ((d[0] + d[1]) + (d[2] + d[3]));
    return rsqrtf(s * (1.0f / 1024.0f) + 1e-6f);
}

using pg8::Unit; using pg8::cvt_pk_bf16;
struct EpiInA {
    static constexpr bool PERM = true, AFTER_DRAIN = false;
    const float* stats; bf16_t* U; bf16_t* CAT; const LAS float* rl; int rl_pm;
    __device__ __forceinline__ void operator()(const f32x4 (&acc)[2][2][4][2], const Unit& u, int wr, int wc, int fr, int fq) const {
        const int row0 = u.pm * 256 + wr * 64 + fr;
#pragma unroll
        for (int ai = 0; ai < 2; ++ai)
#pragma unroll
            for (int m = 0; m < 4; ++m) {
                const int row = row0 + ai * 128 + m * 16; const float rs = (rl && u.pm == rl_pm) ? rl[row - rl_pm * 256] : row_rstd(stats, row);
                if (u.pn < 6) {
                    const float r2 = rs * rs;
                    const f32x4 v0 = acc[ai][0][m][0] * acc[ai][1][m][0] * r2, v1 = acc[ai][0][m][1] * acc[ai][1][m][1] * r2;
                    u32x4 w; w.x = cvt_pk_bf16(v0[0], v0[1]); w.y = cvt_pk_bf16(v0[2], v0[3]); w.z = cvt_pk_bf16(v1[0], v1[1]); w.w = cvt_pk_bf16(v1[2], v1[3]);
                    st16_wt(U + (size_t)row * 768 + u.pn * 128 + wc * 32 + fq * 8, w);
                } else {
                    const int cbase = (u.pn - 6) * 256 + wc * 32 + fq * 8;
#pragma unroll
                    for (int bj = 0; bj < 2; ++bj) {
                        const f32x4 v0 = acc[ai][bj][m][0] * rs, v1 = acc[ai][bj][m][1] * rs;
                        u32x4 w; w.x = cvt_pk_bf16(v0[0], v0[1]); w.y = cvt_pk_bf16(v0[2], v0[3]); w.z = cvt_pk_bf16(v1[0], v1[1]); w.w = cvt_pk_bf16(v1[2], v1[3]);
                        st16_wt(CAT + (size_t)row * 1024 + cbase + bj * 128, w);
                    }
                }
                asm volatile("" ::: "memory");
            }
    }
};
template <int ACT> struct EpiBf16 {
    static constexpr bool PERM = true, AFTER_DRAIN = false;
    const float* stats; int N1; bf16_t* P1; int ld1; bf16_t* P2; int ld2; const LAS float* rl; int rl_pm;
    __device__ __forceinline__ void operator()(const f32x4 (&acc)[2][2][4][2], const Unit& u, int wr, int wc, int fr, int fq) const {
        const int row0 = u.pm * 256 + wr * 64 + fr; int colt = u.pn * 256; bf16_t* base = P1; int ld = ld1;
        if (colt >= N1) { colt -= N1; base = P2; ld = ld2; }
        const int col0 = colt + wc * 32 + fq * 8;
#pragma unroll
        for (int ai = 0; ai < 2; ++ai)
#pragma unroll
            for (int m = 0; m < 4; ++m) {
                const int row = row0 + ai * 128 + m * 16; const float rs = stats ? ((rl && u.pm == rl_pm) ? rl[row - rl_pm * 256] : row_rstd(stats, row)) : 1.0f;
#pragma unroll
                for (int bj = 0; bj < 2; ++bj) {
                    f32x4 v0 = acc[ai][bj][m][0] * rs, v1 = acc[ai][bj][m][1] * rs;
                    if (ACT == 1) {
#pragma unroll
                        for (int e = 0; e < 4; ++e) { const float a = fmaxf(v0[e], 0.f), b = fmaxf(v1[e], 0.f); v0[e] = a * a; v1[e] = b * b; }
                    }
                    u32x4 w; w.x = cvt_pk_bf16(v0[0], v0[1]); w.y = cvt_pk_bf16(v0[2], v0[3]); w.z = cvt_pk_bf16(v1[0], v1[1]); w.w = cvt_pk_bf16(v1[2], v1[3]);
                    st16_wt(base + (size_t)row * ld + col0 + bj * 128, w);
                }
                asm volatile("" ::: "memory");
            }
    }
};
struct EpiRes {
    static constexpr bool PERM = true, AFTER_DRAIN = false;
    float* out; bf16_t* xb; float* stats;
    __device__ __forceinline__ void operator()(const f32x4 (&acc)[2][2][4][2], const Unit& u, int wr, int wc, int fr, int fq) const {
        const int row0 = u.pm * 256 + wr * 64 + fr; const int col0 = u.pn * 256 + wc * 32 + fq * 8;
#pragma unroll
        for (int ai = 0; ai < 2; ++ai)
#pragma unroll
            for (int m = 0; m < 4; ++m) {
                const int row = row0 + ai * 128 + m * 16; float ss = 0.f;
#pragma unroll
                for (int bj = 0; bj < 2; ++bj) {
                    const size_t off = (size_t)row * 1024 + col0 + bj * 128;
                    const u32x4 b = *(const u32x4*)(xb + off);
                    const f32x4 b0 = {bf_lo(b.x), bf_hi(b.x), bf_lo(b.y), bf_hi(b.y)}, b1 = {bf_lo(b.z), bf_hi(b.z), bf_lo(b.w), bf_hi(b.w)};
                    const f32x4 v0 = acc[ai][bj][m][0] + b0, v1 = acc[ai][bj][m][1] + b1;
                    if (out) { *(f32x4*)(out + off) = v0; *(f32x4*)(out + off + 4) = v1; }
                    ss += (v0[0] * v0[0] + v0[1] * v0[1]) + (v0[2] * v0[2] + v0[3] * v0[3]) + (v1[0] * v1[0] + v1[1] * v1[1]) + (v1[2] * v1[2] + v1[3] * v1[3]);
                    u32x4 w; w.x = cvt_pk_bf16(v0[0], v0[1]); w.y = cvt_pk_bf16(v0[2], v0[3]); w.z = cvt_pk_bf16(v1[0], v1[1]); w.w = cvt_pk_bf16(v1[2], v1[3]);
                    *(u32x4*)(xb + off) = w;
                }
                ss += __shfl_xor(ss, 16); ss += __shfl_xor(ss, 32);
                if (fq == 0) stats[(size_t)row * 16 + u.pn * 4 + wc] = ss;
                asm volatile("" ::: "memory");
            }
    }
};

__device__ __forceinline__ void ti_load(f32x4 (&v)[8], const float* W, int N, int src_col0, int k0, int lane) {
#pragma unroll
    for (int r = 0; r < 8; ++r) { const int kk = 8 * r + (lane >> 3), n4 = (lane & 7) * 4;
        v[r] = __builtin_nontemporal_load((const f32x4*)(W + (size_t)(k0 + kk) * N + src_col0 + n4)); }
}
__device__ __forceinline__ void ti_finish(const f32x4 (&v)[8], const float* g, bf16_t* WT, int K, int dst_row0, int k0, LAS float* scr, int lane) {
    const int c = lane & 7;
    f32x4 ga = {1.f, 1.f, 1.f, 1.f}, gb = {1.f, 1.f, 1.f, 1.f};
    if (g) { ga = *(const f32x4*)(g + k0 + 8 * c); gb = *(const f32x4*)(g + k0 + 8 * c + 4); }
#pragma unroll
    for (int r = 0; r < 8; ++r) { const int kk = 8 * r + (lane >> 3), n4 = (lane & 7) * 4; LAS float* d = scr + kk * 33 + n4; d[0] = v[r][0]; d[1] = v[r][1]; d[2] = v[r][2]; d[3] = v[r][3]; }
    LDS_WAIT(); asm volatile("" ::: "memory");
#pragma unroll
    for (int j = 0; j < 4; ++j) { const int n = (lane >> 3) + 8 * j; const LAS float* s = scr + (8 * c) * 33 + n;
        u32x4 o; o.x = cvt_pk_bf16(s[0 * 33] * ga[0], s[1 * 33] * ga[1]); o.y = cvt_pk_bf16(s[2 * 33] * ga[2], s[3 * 33] * ga[3]); o.z = cvt_pk_bf16(s[4 * 33] * gb[0], s[5 * 33] * gb[1]); o.w = cvt_pk_bf16(s[6 * 33] * gb[2], s[7 * 33] * gb[3]);
        *(u32x4*)(WT + (size_t)(dst_row0 + n) * K + k0 + 8 * c) = o; }
    LDS_WAIT(); asm volatile("" ::: "memory");
}
template <int MODE>
__device__ __forceinline__ int conv_src_col(int n0) {
    if (MODE == 1) { const int pn = n0 >> 8, within = n0 & 255;
        if (pn < 6) return ((within >> 7) ? 1536 : 768) + pn * 128 + (within & 127);
        if (pn < 9) return n0 - 1536; }
    return n0;
}
template <int MODE>
__device__ __forceinline__ void convert_job(int& base, int gw, int NGW, const float* W, int K, int Nsrc, int Ndst, const float* g, bf16_t* WT, int dst_row_base, int src_col_base, LAS float* scr, int lane) {
    const int nblk = Ndst / 32, n = (K / 64) * nblk;
    int it = (gw - base) % NGW; if (it < 0) it += NGW;
    f32x4 vc[8], vn[8];
    if (it < n) ti_load(vc, W, Nsrc, src_col_base + conv_src_col<MODE>((it % nblk) * 32), (it / nblk) * 64, lane);
    while (it < n) {
        const int itn = it + NGW;
        if (itn < n) ti_load(vn, W, Nsrc, src_col_base + conv_src_col<MODE>((itn % nblk) * 32), (itn / nblk) * 64, lane);
        ti_finish(vc, g, WT, K, dst_row_base + (it % nblk) * 32, (it / nblk) * 64, scr, lane);
#pragma unroll
        for (int r = 0; r < 8; ++r) vc[r] = vn[r];
        it = itn;
    }
    base += n;
}

__device__ __forceinline__ void rope_cs(int pos, int i, float& c, float& s) {
    const float inv = 1.0f / exp2f((float)i * (18.931568569324174f / 8.0f));
    const float ang = (float)pos * inv;
    double rev = (double)ang * 0.15915494309189535; rev -= __builtin_floor(rev);
    const float fr = (float)rev;
    c = __builtin_amdgcn_cosf(fr); s = __builtin_amdgcn_sinf(fr);
}
__device__ __forceinline__ int sigma_pos(int p) { return (p & ~12) | ((p & 4) << 1) | ((p & 8) >> 1); }

template <bool ROPE, int VD, int NMAPS>
__device__ __forceinline__ void kv_post_item(const bf16_t* src, int ld, int kcol0, int mapstride, int vcol0, int row0, const float* kg, unsigned char* img, int lane) {
#pragma unroll 1
    for (int map = 0; map < NMAPS; ++map) {
        const bf16_t* kr = src + (size_t)(row0 + lane) * ld + kcol0 + map * mapstride;
        float v[64]; float ss = 0.f;
#pragma unroll
        for (int c = 0; c < 8; ++c) { const u32x4 w = *(const u32x4*)(kr + 8 * c);
            v[8 * c + 0] = bf_lo(w.x); v[8 * c + 1] = bf_hi(w.x); v[8 * c + 2] = bf_lo(w.y); v[8 * c + 3] = bf_hi(w.y);
            v[8 * c + 4] = bf_lo(w.z); v[8 * c + 5] = bf_hi(w.z); v[8 * c + 6] = bf_lo(w.w); v[8 * c + 7] = bf_hi(w.w); }
#pragma unroll
        for (int d = 0; d < 64; ++d) ss += v[d] * v[d];
        const float rstd = rsqrtf(ss * (1.0f / 64.0f) + 1e-6f);
#pragma unroll
        for (int d = 0; d < 64; ++d) v[d] = v[d] * rstd * kg[d];
        if (ROPE) {
#pragma unroll
            for (int i = 0; i < 8; ++i) { float c, s; rope_cs(row0 + lane, i, c, s); const float x1 = v[i], x2 = v[i + 8]; v[i] = x1 * c - x2 * s; v[i + 8] = x1 * s + x2 * c; }
        }
        unsigned char* dst = img + map * 8192 + sigma_pos(lane) * 16;
#pragma unroll
        for (int c = 0; c < 8; ++c) { u32x4 w; w.x = cvt_pk_bf16(v[8 * c + 0], v[8 * c + 1]); w.y = cvt_pk_bf16(v[8 * c + 2], v[8 * c + 3]);
            w.z = cvt_pk_bf16(v[8 * c + 4], v[8 * c + 5]); w.w = cvt_pk_bf16(v[8 * c + 6], v[8 * c + 7]); *(u32x4*)(dst + c * 1024) = w; }
    }
#pragma unroll 1
    for (int pass = 0; pass < VD / 64; ++pass) {
        const int d = lane + 64 * pass;
        const bf16_t* vp = src + (size_t)row0 * ld + vcol0 + d;
        unsigned char* dst = img + NMAPS * 8192 + d * 16;
#pragma unroll
        for (int c = 0; c < 8; ++c) {
            unsigned e[8];
#pragma unroll
            for (int i = 0; i < 8; ++i) e[i] = vp[(size_t)(8 * c + i) * ld];
            u32x4 w; w.x = e[0] | (e[1] << 16); w.y = e[2] | (e[3] << 16); w.z = e[4] | (e[5] << 16); w.w = e[6] | (e[7] << 16);
            *(u32x4*)(dst + c * (VD * 16)) = w;
        }
    }
}

__device__ __forceinline__ void glds16(const void* gsrc, unsigned lds_dst) { unsigned keep;
    asm volatile("s_mov_b32 %0, m0\n\ts_mov_b32 m0, %2\n\ts_nop 0\n\tglobal_load_lds_dwordx4 %1, off\n\ts_mov_b32 m0, %0" : "=&s"(keep) : "v"(gsrc), "s"(lds_dst) : "memory"); }

template <bool DIFF>
__device__ __forceinline__ void attn_unit(LAS unsigned char* lds, const bf16_t* Qp, int qld, const float* qg, const unsigned char* img, int ntiles, int q0,
                                          bf16_t* Op, int old, float negM, float lam, const float* subg, float oscale) {
    constexpr int IMG = DIFF ? 32768 : 16384, VOFF = DIFF ? 16384 : 8192, NDB = DIFF ? 4 : 2, VCH = DIFF ? 2048 : 1024, NLD = IMG / 8192;
    int tid_ = threadIdx.x; asm volatile("" : "+v"(tid_));
    const int tid = tid_, lane = tid & 63, r32 = lane & 31, hi = lane >> 5;
    const int wid = __builtin_amdgcn_readfirstlane(tid >> 6);
    const int map = DIFF ? (wid >> 2) : 0, wq = DIFF ? (wid & 3) : wid;
    const int row = q0 + 32 * wq + r32;
    const int tlim = DIFF ? ((q0 + 32 * wq) >> 6) : (ntiles - 1);
    u32x4 stg[NLD], stg1[NLD];
    { const u32x4* g0 = (const u32x4*)img + tid;
#pragma unroll
      for (int k = 0; k < NLD; ++k) stg[k] = g0[k * 512];
      if (ntiles > 1) {
#pragma unroll
          for (int k = 0; k < NLD; ++k) stg1[k] = g0[IMG / 16 + k * 512]; } }
    bf16x8 qf[4];
    {
        const bf16_t* qrow = Qp + (size_t)row * qld + map * 384 + hi * 8;
        float qv[4][8]; float ss = 0.f;
#pragma unroll
        for (int d0 = 0; d0 < 4; ++d0) { const u32x4 w = *(const u32x4*)(qrow + 16 * d0);
            qv[d0][0] = bf_lo(w.x); qv[d0][1] = bf_hi(w.x); qv[d0][2] = bf_lo(w.y); qv[d0][3] = bf_hi(w.y);
            qv[d0][4] = bf_lo(w.z); qv[d0][5] = bf_hi(w.z); qv[d0][6] = bf_lo(w.w); qv[d0][7] = bf_hi(w.w); }
#pragma unroll
        for (int d0 = 0; d0 < 4; ++d0)
#pragma unroll
            for (int i = 0; i < 8; ++i) ss += qv[d0][i] * qv[d0][i];
        ss += __shfl_xor(ss, 32);
        const float rstd = rsqrtf(ss * (1.0f / 64.0f) + 1e-6f);
#pragma unroll
        for (int d0 = 0; d0 < 4; ++d0) { const f32x4 g0 = *(const f32x4*)(qg + 16 * d0 + 8 * hi), g1 = *(const f32x4*)(qg + 16 * d0 + 8 * hi + 4);
#pragma unroll
            for (int i = 0; i < 4; ++i) { qv[d0][i] *= rstd * g0[i]; qv[d0][4 + i] *= rstd * g1[i]; } }
        if (DIFF) {
#pragma unroll
            for (int i = 0; i < 8; ++i) { float c, s; rope_cs(row, i, c, s); const float p = __shfl_xor(qv[0][i], 32);
                qv[0][i] = hi == 0 ? (qv[0][i] * c - p * s) : (p * s + qv[0][i] * c); }
        }
        const float QS = 0.125f * 1.4426950408889634f;
#pragma unroll
        for (int d0 = 0; d0 < 4; ++d0) { u32x4 w; w.x = cvt_pk_bf16(qv[d0][0] * QS, qv[d0][1] * QS); w.y = cvt_pk_bf16(qv[d0][2] * QS, qv[d0][3] * QS);
            w.z = cvt_pk_bf16(qv[d0][4] * QS, qv[d0][5] * QS); w.w = cvt_pk_bf16(qv[d0][6] * QS, qv[d0][7] * QS); qf[d0] = __builtin_bit_cast(bf16x8, w); }
    }
#pragma unroll
    for (int k = 0; k < NLD; ++k) *(LAS u32x4*)(lds + (size_t)(tid + 512 * k) * 16) = stg[k];
    if (ntiles > 1) {
#pragma unroll
        for (int k = 0; k < NLD; ++k) *(LAS u32x4*)(lds + IMG + (size_t)(tid + 512 * k) * 16) = stg1[k]; }
    __syncthreads();
    f32x16 o[NDB];
#pragma unroll
    for (int db = 0; db < NDB; ++db)
#pragma unroll
        for (int r = 0; r < 16; ++r) o[db][r] = 0.f;
    float lsum = 0.f;
    const f32x16 negv = {0.f, 0.f, 0.f, 0.f, 0.f, 0.f, 0.f, 0.f, 0.f, 0.f, 0.f, 0.f, 0.f, 0.f, 0.f, 0.f}; (void)negM;
    f32x16 s0, s1; bf16x8 pw[4];
    constexpr int NPV = NDB * 4, EPM = 32 / NPV;
    const int koff = map * 8192 + hi * 1024 + r32 * 16, voff = VOFF + hi * VCH + r32 * 16;
#define ATT_KLD(kf_, bufp) do { const LAS unsigned char* kb_ = (bufp) + koff; \
        _Pragma("unroll") for (int d0 = 0; d0 < 4; ++d0) { kf_[2 * d0] = *(const LAS bf16x8*)(kb_ + d0 * 2048); kf_[2 * d0 + 1] = *(const LAS bf16x8*)(kb_ + d0 * 2048 + 512); } } while (0)
#define ATT_QKM(kf_) do { \
        s0 = __builtin_amdgcn_mfma_f32_32x32x16_bf16(kf_[0], qf[0], negv, 0, 0, 0); s1 = __builtin_amdgcn_mfma_f32_32x32x16_bf16(kf_[1], qf[0], negv, 0, 0, 0); \
        _Pragma("unroll") for (int d0 = 1; d0 < 4; ++d0) { s0 = __builtin_amdgcn_mfma_f32_32x32x16_bf16(kf_[2 * d0], qf[d0], s0, 0, 0, 0); s1 = __builtin_amdgcn_mfma_f32_32x32x16_bf16(kf_[2 * d0 + 1], qf[d0], s1, 0, 0, 0); } } while (0)
#define ATT_SUMPACK() do { float a0_ = 0.f, a1_ = 0.f; \
        _Pragma("unroll") for (int r = 0; r < 16; ++r) { a0_ += s0[r]; a1_ += s1[r]; } \
        lsum += a0_ + a1_; u32x4 w_; \
        w_.x = cvt_pk_bf16(s0[0], s0[1]); w_.y = cvt_pk_bf16(s0[2], s0[3]); w_.z = cvt_pk_bf16(s0[4], s0[5]); w_.w = cvt_pk_bf16(s0[6], s0[7]); pw[0] = __builtin_bit_cast(bf16x8, w_); \
        w_.x = cvt_pk_bf16(s0[8], s0[9]); w_.y = cvt_pk_bf16(s0[10], s0[11]); w_.z = cvt_pk_bf16(s0[12], s0[13]); w_.w = cvt_pk_bf16(s0[14], s0[15]); pw[1] = __builtin_bit_cast(bf16x8, w_); \
        w_.x = cvt_pk_bf16(s1[0], s1[1]); w_.y = cvt_pk_bf16(s1[2], s1[3]); w_.z = cvt_pk_bf16(s1[4], s1[5]); w_.w = cvt_pk_bf16(s1[6], s1[7]); pw[2] = __builtin_bit_cast(bf16x8, w_); \
        w_.x = cvt_pk_bf16(s1[8], s1[9]); w_.y = cvt_pk_bf16(s1[10], s1[11]); w_.z = cvt_pk_bf16(s1[12], s1[13]); w_.w = cvt_pk_bf16(s1[14], s1[15]); pw[3] = __builtin_bit_cast(bf16x8, w_); } while (0)
#define ATT_VLD(vbp, i) (*(const LAS bf16x8*)((vbp) + (2 * ((i) / NDB)) * VCH + ((i) % NDB) * 512))
    { bf16x8 kf[8]; ATT_KLD(kf, lds); ATT_QKM(kf); }
#pragma unroll
    for (int r = 0; r < 16; ++r) { s0[r] = __builtin_amdgcn_exp2f(s0[r]); s1[r] = __builtin_amdgcn_exp2f(s1[r]); }
    int offV = 0, offK = IMG, offS = 2 * IMG;
    const unsigned ldsbase = (unsigned)(uintptr_t)lds;
    if (wid >= 4) __builtin_amdgcn_s_setprio(1);
    constexpr int LA = 4;
#pragma unroll 1
    for (int t = 0; t < ntiles; ++t) {
        const bool more2 = (t + 2 < ntiles);
        const LAS unsigned char* vb = lds + offV + voff;
        if (t < tlim) {
            bf16x8 kf[8];
            ATT_KLD(kf, lds + offK);
            if (more2) { const unsigned char* g = img + (size_t)(t + 2) * IMG + wid * 1024 + lane * 16;
#pragma unroll
                for (int k = 0; k < NLD; ++k) glds16(g + k * 8192, (unsigned)__builtin_amdgcn_readfirstlane((int)(ldsbase + offS + wid * 1024 + k * 8192))); }
            __builtin_amdgcn_sched_barrier(0);
            ATT_SUMPACK();
            __builtin_amdgcn_sched_barrier(0);
            ATT_QKM(kf);
            bf16x8 vfr[4];
#pragma unroll
            for (int i = 0; i < LA; ++i) vfr[i] = ATT_VLD(vb, i);
            __builtin_amdgcn_sched_barrier(0);
#pragma unroll
            for (int i = 0; i < NPV; ++i) {
                o[i % NDB] = __builtin_amdgcn_mfma_f32_32x32x16_bf16(vfr[i & 3], pw[i / NDB], o[i % NDB], 0, 0, 0);
                if (i + LA < NPV) vfr[i & 3] = ATT_VLD(vb, i + LA);
#pragma unroll
                for (int e = 0; e < EPM; ++e) { const int k = i * EPM + e; if (k < 16) s0[k] = __builtin_amdgcn_exp2f(s0[k]); else s1[k - 16] = __builtin_amdgcn_exp2f(s1[k - 16]); }
                __builtin_amdgcn_sched_barrier(0);
            }
        } else {
            if (more2) { const unsigned char* g = img + (size_t)(t + 2) * IMG + wid * 1024 + lane * 16;
#pragma unroll
                for (int k = 0; k < NLD; ++k) glds16(g + k * 8192, (unsigned)__builtin_amdgcn_readfirstlane((int)(ldsbase + offS + wid * 1024 + k * 8192))); }
            if (t == tlim) {
                ATT_SUMPACK();
#pragma unroll
                for (int i = 0; i < NPV; ++i) { const bf16x8 vf = ATT_VLD(vb, i); o[i % NDB] = __builtin_amdgcn_mfma_f32_32x32x16_bf16(vf, pw[i / NDB], o[i % NDB], 0, 0, 0); }
            }
        }
        asm volatile("s_waitcnt vmcnt(0)" ::: "memory");
        __syncthreads();
        { const int tmp = offV; offV = offK; offK = offS; offS = tmp; }
    }
    __builtin_amdgcn_s_setprio(0);
#undef ATT_KLD
#undef ATT_QKM
#undef ATT_SUMPACK
#undef ATT_VLD
    const float l = lsum + __shfl_xor(lsum, 32);
    const float inv = 1.0f / l;
    if (DIFF) {
        LAS float* ex = (LAS float*)lds;
        if (map == 1) {
#pragma unroll
            for (int db = 0; db < NDB; ++db)
#pragma unroll
                for (int r = 0; r < 16; ++r) ex[((wq * NDB + db) * 16 + r) * 64 + lane] = o[db][r] * inv;
        }
        __syncthreads();
        if (map == 0) {
            float ss = 0.f;
#pragma unroll
            for (int db = 0; db < NDB; ++db)
#pragma unroll
                for (int r = 0; r < 16; ++r) { const float v = o[db][r] * inv - lam * ex[((wq * NDB + db) * 16 + r) * 64 + lane]; o[db][r] = v; ss += v * v; }
            ss += __shfl_xor(ss, 32);
            const float rs = rsqrtf(ss * (1.0f / 128.0f) + 1e-5f) * oscale;
            bf16_t* orow = Op + (size_t)row * old + 4 * hi;
#pragma unroll
            for (int db = 0; db < NDB; ++db)
#pragma unroll
                for (int rq = 0; rq < 4; ++rq) { const int d = 32 * db + 8 * rq; const f32x4 g = *(const f32x4*)(subg + d + 4 * hi);
                    u32x2 w; w.x = cvt_pk_bf16(o[db][4 * rq + 0] * rs * g[0], o[db][4 * rq + 1] * rs * g[1]); w.y = cvt_pk_bf16(o[db][4 * rq + 2] * rs * g[2], o[db][4 * rq + 3] * rs * g[3]);
                    st8_wt(orow + d, w); }
        }
        __syncthreads();
    } else {
        bf16_t* orow = Op + (size_t)row * old + 4 * hi;
#pragma unroll
        for (int db = 0; db < NDB; ++db)
#pragma unroll
            for (int rq = 0; rq < 4; ++rq) { const int d = 32 * db + 8 * rq;
                u32x2 w; w.x = cvt_pk_bf16(o[db][4 * rq + 0] * inv, o[db][4 * rq + 1] * inv); w.y = cvt_pk_bf16(o[db][4 * rq + 2] * inv, o[db][4 * rq + 3] * inv);
                st8_wt(orow + d, w); }
    }
}

__device__ const unsigned short kAttnSched[768] = {126, 39, 25, 109, 42, 40, 92, 55, 43, 115, 167, 37, 237, 44, 165, 127, 47, 16, 255, 51, 13, 93, 179, 175, 104, 46, 41, 122, 170, 27, 123, 63, 5, 121, 169, 29, 102, 48, 168, 112, 296, 295, 105, 45, 297, 99, 174, 173, 249, 69, 0, 119, 293, 34, 383, 302, 17, 377, 298, 28, 90, 307, 49, 89, 57, 301, 124, 177, 18, 120, 58, 141, 107, 430, 38, 511, 171, 21, 83, 54, 182, 111, 425, 423, 252, 185, 10, 114, 53, 24, 211, 313, 50, 248, 191, 7, 85, 56, 305, 101, 183, 35, 380, 59, 135, 125, 60, 6, 254, 176, 145, 118, 424, 33, 253, 299, 23, 339, 73, 163, 250, 291, 162, 117, 303, 155, 246, 166, 419, 116, 172, 30, 376, 421, 161, 378, 184, 269, 505, 186, 12, 382, 304, 144, 508, 547, 31, 633, 178, 19, 239, 427, 549, 103, 181, 290, 247, 52, 20, 375, 552, 32, 374, 680, 289, 98, 435, 426, 86, 309, 180, 232, 308, 418, 504, 311, 272, 245, 306, 152, 373, 555, 159, 242, 300, 160, 100, 314, 288, 501, 554, 416, 629, 429, 157, 110, 434, 287, 244, 558, 156, 372, 683, 415, 77, 188, 310, 500, 557, 158, 370, 431, 286, 113, 432, 414, 243, 686, 542, 106, 436, 417, 498, 562, 283, 233, 312, 670, 632, 442, 397, 628, 553, 546, 503, 437, 146, 87, 564, 563, 230, 441, 544, 228, 316, 543, 371, 438, 22, 502, 428, 285, 499, 559, 284, 251, 440, 140, 241, 433, 413, 235, 439, 541, 379, 187, 8, 626, 690, 411, 627, 561, 539, 76, 68, 687, 221, 197, 412, 231, 570, 669, 240, 566, 153, 369, 565, 280, 367, 694, 26, 495, 568, 408, 365, 569, 536, 756, 315, 15, 623, 567, 281, 630, 560, 409, 214, 443, 685, 757, 688, 154, 238, 693, 667, 360, 444, 282, 497, 66, 11, 366, 695, 410, 381, 62, 3, 636, 697, 9, 488, 61, 538, 493, 189, 149, 639, 317, 131, 108, 572, 151, 234, 445, 279, 494, 190, 274, 621, 571, 407, 236, 698, 664, 364, 573, 150, 622, 701, 147, 362, 318, 278, 220, 446, 677, 368, 201, 134, 78, 204, 36, 625, 319, 14, 363, 447, 277, 348, 575, 164, 95, 703, 545, 490, 64, 405, 631, 574, 138, 618, 192, 148, 746, 320, 533, 361, 194, 276, 358, 196, 404, 359, 67, 532, 487, 65, 535, 491, 322, 402, 507, 193, 2, 492, 448, 275, 635, 321, 259, 215, 450, 294, 75, 578, 689, 486, 70, 530, 763, 576, 4, 749, 449, 273, 226, 81, 139, 620, 195, 400, 217, 323, 675, 614, 451, 406, 354, 72, 660, 229, 325, 661, 509, 577, 1, 616, 198, 401, 751, 324, 268, 742, 200, 528, 637, 692, 525, 82, 328, 292, 80, 452, 682, 97, 453, 537, 482, 84, 136, 760, 579, 387, 349, 210, 143, 767, 704, 128, 750, 581, 267, 94, 208, 529, 356, 203, 271, 758, 326, 515, 484, 332, 142, 227, 205, 270, 615, 329, 398, 467, 71, 420, 743, 457, 526, 610, 79, 653, 355, 74, 657, 223, 454, 665, 759, 582, 130, 331, 199, 556, 342, 456, 672, 755, 327, 133, 225, 584, 534, 353, 338, 396, 765, 691, 654, 510, 705, 256, 351, 712, 663, 222, 209, 399, 481, 202, 403, 96, 696, 422, 224, 470, 264, 476, 91, 263, 489, 330, 395, 638, 699, 261, 609, 337, 524, 619, 458, 266, 479, 460, 531, 477, 343, 394, 213, 459, 671, 357, 336, 137, 738, 588, 656, 219, 218, 265, 347, 346, 393, 206, 716, 548, 587, 586, 681, 612, 465, 521, 605, 345, 392, 471, 455, 673, 352, 341, 649, 740, 466, 520, 474, 602, 522, 350, 333, 659, 496, 461, 258, 753, 710, 391, 748, 589, 389, 747, 334, 517, 207, 462, 674, 733, 475, 262, 478, 603, 390, 590, 717, 676, 764, 700, 519, 606, 88, 648, 335, 585, 550, 761, 580, 129, 624, 718, 257, 473, 598, 527, 480, 216, 518, 483, 464, 523, 344, 715, 540, 734, 604, 132, 730, 601, 652, 593, 706, 684, 485, 469, 260, 592, 583, 551, 607, 731, 388, 506, 709, 384, 732, 599, 651, 617, 721, 516, 463, 713, 679, 634, 707, 386, 726, 594, 662, 762, 708, 385, 737, 595, 650, 722, 711, 678, 212, 720, 666, 754, 714, 514, 744, 340, 642, 608, 729, 645, 745, 468, 513, 723, 591, 668, 611, 597, 646, 613, 472, 641, 741, 725, 644, 739, 596, 647, 752, 719, 512, 736, 735, 640, 766, 702, 643, 600, 724, 658, 728, 727, 655};

__device__ __forceinline__ float max_abs64(const float* g) { float m = 0.f; for (int i = 0; i < 64; ++i) m = fmaxf(m, fabsf(g[i])); return m; }

#define XB_TMO      128
#define XB_XCNT(j)  (256  + 64 * (j))
#define XB_XSUB(j)  (1280 + 64 * (j))
#define XB_XGEN(j)  (2304 + 64 * (j))
#define XB_TOP      3328
#define XB_TOPGEN   3392
#define XCD_BAR_WORDS 3456
#define XB_SPIN_CAP (1u << 18)

__device__ __forceinline__ unsigned xb_ld(unsigned* p)              { return __hip_atomic_load(p, __ATOMIC_RELAXED, __HIP_MEMORY_SCOPE_AGENT); }
__device__ __forceinline__ unsigned xb_add(unsigned* p, unsigned v) { return __hip_atomic_fetch_add(p, v, __ATOMIC_RELAXED, __HIP_MEMORY_SCOPE_AGENT); }
__device__ __forceinline__ unsigned xb_xcc_id() { return (unsigned)__builtin_amdgcn_s_getreg((3 << 11) | 20) & 0xFu; }
#define XB_SPIN(cond, bar) do { unsigned _sp = 0; while (cond) { __builtin_amdgcn_s_sleep(1); \
    if ((++_sp & 255u) == 0u) { if (xb_ld(&(bar)[XB_TMO])) break; if (_sp > XB_SPIN_CAP) { atomicAdd(&(bar)[XB_TMO], 1u); break; } } } } while (0)

struct XcdBarrier {
    unsigned* bar; unsigned x;
    volatile LAS unsigned* st;
};

__device__ __forceinline__ XcdBarrier xcd_barrier_post(unsigned* bar, volatile LAS unsigned* st) {
    XcdBarrier b; b.bar = bar; b.x = xb_xcc_id(); b.st = st;
    if (threadIdx.x == 0) (void)xb_add(&bar[XB_XCNT(b.x)], 1u);
    return b;
}
__device__ __forceinline__ void xcd_barrier_complete(unsigned* bar, unsigned x, unsigned& nloc, unsigned& nx) {
    const unsigned G = gridDim.x * gridDim.y * gridDim.z;
    unsigned sum, cnt, mine, sp = 0u;
    for (;;) {
        sum = 0u; cnt = 0u; mine = 0u;
#pragma unroll
        for (unsigned j = 0; j < 16; ++j) { const unsigned c = xb_ld(&bar[XB_XCNT(j)]); sum += c; cnt += (c > 0u) ? 1u : 0u; mine = (j == x) ? c : mine; }
        if (sum == G) break;
        __builtin_amdgcn_s_sleep(1);
        if ((++sp & 255u) == 0u) { if (xb_ld(&bar[XB_TMO])) break; if (sp > XB_SPIN_CAP) { atomicAdd(&bar[XB_TMO], 1u); break; } }
    }
    nloc = mine > 0u ? mine : 1u; nx = cnt > 0u ? cnt : 1u;
}

__device__ __forceinline__ void xcd_barrier(const XcdBarrier& b) {
    asm volatile("s_waitcnt vmcnt(0)" ::: "memory");
    __syncthreads();
    if (threadIdx.x == 0) {
        unsigned* bar = b.bar;
        __builtin_amdgcn_s_waitcnt(0);
        unsigned nloc = b.st[0], nx = b.st[1];
        if (nloc == 0u) { xcd_barrier_complete(bar, b.x, nloc, nx); b.st[0] = nloc; b.st[1] = nx; }
        const unsigned old = xb_add(&bar[XB_XSUB(b.x)], 1u);
        const unsigned gen = old / nloc;
        if (old + 1u == (gen + 1u) * nloc) {
            __builtin_amdgcn_fence(__ATOMIC_RELEASE, "agent");
            asm volatile("s_waitcnt vmcnt(0)" ::: "memory");
            const unsigned og = xb_add(&bar[XB_TOP], 1u);
            const unsigned tg = og / nx;
            if (og + 1u == (tg + 1u) * nx) xb_add(&bar[XB_TOPGEN], 1u);
            else XB_SPIN(xb_ld(&bar[XB_TOPGEN]) == tg, bar);
            __builtin_amdgcn_fence(__ATOMIC_ACQUIRE, "agent");
            xb_add(&bar[XB_XGEN(b.x)], 1u);
            asm volatile("s_waitcnt vmcnt(0)" ::: "memory");
        } else {
            XB_SPIN(xb_ld(&bar[XB_XGEN(b.x)]) == gen, bar);
            __builtin_amdgcn_fence(__ATOMIC_ACQUIRE, "agent");
            asm volatile("s_waitcnt vmcnt(0)" ::: "memory");
        }
    }
    __syncthreads();
}

__device__ __forceinline__ int panel_rstd_to_lds(LAS unsigned char* lds, const float* stats, const pg8::StaticOrder& S) {
    pg8::Unit u0; const bool has = S.next(0, u0);
    LAS float* rl = (LAS float*)(lds + MISC_OFF + 1024);
    if (has && threadIdx.x < 256) rl[threadIdx.x] = row_rstd(stats, u0.pm * 256 + (int)threadIdx.x);
    __syncthreads();
    return has ? u0.pm : -1;
}

__device__ __forceinline__ void prologue_body(const Args& a, LAS unsigned char* lds) {
    int tid_ = threadIdx.x; asm volatile("" : "+v"(tid_)); const int tid = tid_, lane = tid & 63, wave = __builtin_amdgcn_readfirstlane(tid >> 6);
    const int G = gridDim.x, bx = blockIdx.x;
    const int gw = bx * NWAVES + wave, NGW = G * NWAVES;
    unsigned char* ws = a.ws;
    float* stats = (float*)(ws + WS_STATS);
    unsigned char* memimg = ws + WS_MEMIMG;
    bf16_t* WinA = (bf16_t*)(ws + WS_WINA); bf16_t* Wqkv = (bf16_t*)(ws + WS_WQKV); bf16_t* Wq1 = (bf16_t*)(ws + WS_WQ1); bf16_t* Wmkv = (bf16_t*)(ws + WS_WMKV);
    bf16_t* Wo = (bf16_t*)(ws + WS_WO); bf16_t* Wup = (bf16_t*)(ws + WS_WUP); bf16_t* Wdn = (bf16_t*)(ws + WS_WDN);
    bf16_t* XB = (bf16_t*)(ws + WS_XB); unsigned char* kvimg = ws + WS_KVIMG; bf16_t* H = (bf16_t*)(ws + WS_H);
    bf16_t* U = (bf16_t*)(ws + WS_U); bf16_t* QB = (bf16_t*)(ws + WS_QB); bf16_t* CAT = (bf16_t*)(ws + WS_CAT); bf16_t* KVB = (bf16_t*)(ws + WS_KVB);
    bf16_t* MEMN = (bf16_t*)(ws + WS_MEMN); bf16_t* MKV = (bf16_t*)(ws + WS_MKV);
    unsigned* ctl = (unsigned*)(ws + WS_CTL);
    LAS float* scr = (LAS float*)(lds + wave * 16384);
    LAS unsigned* misc = (LAS unsigned*)(lds + MISC_OFF);

    {
        int base = 0; const bool defer = (G == 256);
        for (int l = 0; l < (defer ? 1 : 2); ++l)
            convert_job<1>(base, gw, NGW, a.a_w_in + (size_t)l * 1024 * 2560, 1024, 2560, 2560, a.norm_mix + l * 1024, WinA + (size_t)l * 2560 * 1024, 0, 0, scr, lane);
        if (!defer) {
            convert_job<0>(base, gw, NGW, a.b_w_q, 1024, 1024, 1024, a.norm_mix + 2 * 1024, Wqkv, 0, 0, scr, lane);
            convert_job<0>(base, gw, NGW, a.w_kv, 1024, 1536, 1536, a.kv_norm, Wqkv, 1024, 0, scr, lane);
            convert_job<0>(base, gw, NGW, a.b_w_q + (size_t)1024 * 1024, 1024, 1024, 1024, a.norm_mix + 3 * 1024, Wq1, 0, 0, scr, lane);
        }
        for (int l = 0; l < 4; ++l) {
            convert_job<0>(base, gw, NGW, a.w_mem_kv + (size_t)l * 1024 * 512, 1024, 512, 512, nullptr, Wmkv, l * 512, 0, scr, lane);
            if (l == 0 || !defer) convert_job<0>(base, gw, NGW, a.w_o + (size_t)l * 1024 * 1024, 1024, 1024, 1024, nullptr, Wo + (size_t)l * 1024 * 1024, 0, 0, scr, lane);
        }
        for (int m0 = gw; m0 < S_; m0 += 4 * NGW) {
            f32x4 v[4][4];
#pragma unroll
            for (int q = 0; q < 4; ++q) { const int m = m0 + q * NGW; if (m < S_) { const f32x4* xr = (const f32x4*)(a.x + (size_t)m * 1024) + lane;
#pragma unroll
                for (int j = 0; j < 4; ++j) v[q][j] = __builtin_nontemporal_load(xr + 64 * j); } }
#pragma unroll
            for (int q = 0; q < 4; ++q) { const int m = m0 + q * NGW; if (m < S_) { float s = 0.f;
#pragma unroll
                for (int j = 0; j < 4; ++j) s += (v[q][j][0] * v[q][j][0] + v[q][j][1] * v[q][j][1]) + (v[q][j][2] * v[q][j][2] + v[q][j][3] * v[q][j][3]);
                s = wave_sum(s);
                u32x2* o8 = (u32x2*)(XB + (size_t)m * 1024) + lane;
#pragma unroll
                for (int j = 0; j < 4; ++j) { u32x2 w; w.x = cvt_pk_bf16(v[q][j][0], v[q][j][1]); w.y = cvt_pk_bf16(v[q][j][2], v[q][j][3]); o8[64 * j] = w; }
                if (lane < 16) stats[(size_t)m * 16 + lane] = lane == 0 ? s : 0.f; } }
        }
        for (int m = gw; m < MEMLEN; m += NGW) {
            const f32x4* xr = (const f32x4*)(a.mem + (size_t)m * 1024) + lane; const f32x4* gr = (const f32x4*)a.mem_norm + lane; f32x4 v[4]; float s = 0.f;
#pragma unroll
            for (int j = 0; j < 4; ++j) { v[j] = xr[64 * j]; s += (v[j][0] * v[j][0] + v[j][1] * v[j][1]) + (v[j][2] * v[j][2] + v[j][3] * v[j][3]); }
            s = wave_sum(s); const float rstd = rsqrtf(s * (1.0f / 1024.0f) + 1e-6f);
            u32x2* o8 = (u32x2*)(MEMN + (size_t)m * 1024) + lane;
#pragma unroll
            for (int j = 0; j < 4; ++j) { const f32x4 g = gr[64 * j]; u32x2 w; w.x = cvt_pk_bf16(v[j][0] * rstd * g[0], v[j][1] * rstd * g[1]); w.y = cvt_pk_bf16(v[j][2] * rstd * g[2], v[j][3] * rstd * g[3]); o8[64 * j] = w; }
        }
    }
}

template <int l>
__device__ __forceinline__ void layer_body(const Args& a, LAS unsigned char* lds, const XcdBarrier& bar) {
    int tid_ = threadIdx.x; asm volatile("" : "+v"(tid_)); const int tid = tid_, lane = tid & 63, wave = __builtin_amdgcn_readfirstlane(tid >> 6);
    const int G = gridDim.x, bx = blockIdx.x;
    const int gw = bx * NWAVES + wave, NGW = G * NWAVES;
    unsigned char* ws = a.ws;
    float* stats = (float*)(ws + WS_STATS);
    unsigned char* memimg = ws + WS_MEMIMG;
    bf16_t* WinA = (bf16_t*)(ws + WS_WINA); bf16_t* Wqkv = (bf16_t*)(ws + WS_WQKV); bf16_t* Wq1 = (bf16_t*)(ws + WS_WQ1); bf16_t* Wmkv = (bf16_t*)(ws + WS_WMKV);
    bf16_t* Wo = (bf16_t*)(ws + WS_WO); bf16_t* Wup = (bf16_t*)(ws + WS_WUP); bf16_t* Wdn = (bf16_t*)(ws + WS_WDN);
    bf16_t* XB = (bf16_t*)(ws + WS_XB); unsigned char* kvimg = ws + WS_KVIMG; bf16_t* H = (bf16_t*)(ws + WS_H);
    bf16_t* U = (bf16_t*)(ws + WS_U); bf16_t* QB = (bf16_t*)(ws + WS_QB); bf16_t* CAT = (bf16_t*)(ws + WS_CAT); bf16_t* KVB = (bf16_t*)(ws + WS_KVB);
    bf16_t* MEMN = (bf16_t*)(ws + WS_MEMN); bf16_t* MKV = (bf16_t*)(ws + WS_MKV);
    unsigned* ctl = (unsigned*)(ws + WS_CTL);
    LAS float* scr = (LAS float*)(lds + wave * 16384);
    LAS unsigned* misc = (LAS unsigned*)(lds + MISC_OFF);

    const float LOG2E = 1.4426950408889634f;
    {
        const bool isA = l < 2; const int j = l - 2;
        if (isA) {
            pg8::Gemm g{XB, WinA + (size_t)l * 2560 * 1024, S_, 2560, 1024}; pg8::StaticOrder S; S.init(S_, 2560, G, bx);
            const int pm0 = panel_rstd_to_lds(lds, stats, S);
            EpiInA E{stats, U, CAT, (const LAS float*)(lds + MISC_OFF + 1024), pm0};
            pg8::gemm_phase<EpiInA, pg8::StaticOrder, true, true>(lds, g, S, E);
            if (l == 0) {
                pg8::Gemm g2{MEMN, Wmkv, MEMLEN, 2048, 1024}; pg8::StaticOrder S2; S2.init(MEMLEN, 2048, G, (bx + 8) % G);
                EpiBf16<0> E2{nullptr, 1 << 30, MKV, 2048, MKV, 2048, nullptr, -1};
                pg8::gemm_phase<EpiBf16<0>, pg8::StaticOrder, true, true>(lds, g2, S2, E2);
            }
        } else {
            const int N = (j == 0) ? 2560 : 1024;
            pg8::Gemm g{XB, j == 0 ? Wqkv : Wq1, S_, N, 1024}; pg8::StaticOrder S; S.init(S_, N, G, bx);
            const int pm0 = panel_rstd_to_lds(lds, stats, S);
            EpiBf16<0> E{stats, 1024, QB, 1024, KVB, 1536, (const LAS float*)(lds + MISC_OFF + 1024), pm0};
            pg8::gemm_phase<EpiBf16<0>, pg8::StaticOrder, true, true>(lds, g, S, E);
        }
        {
            const bool half = (l < 3) && (G == 256);
            const int nconv = (l == 0) ? 120 : 128;
            if (!half || (bx >= 128 && bx < 128 + nconv)) {
                int base = 0; const int gw2 = half ? gw - 128 * NWAVES : gw, NGW2 = half ? nconv * NWAVES : NGW;
                if (l < 3) {
                    convert_job<0>(base, gw2, NGW2, a.w_up + (size_t)l * 1024 * 4096, 1024, 4096, 4096, a.norm_mlp + l * 1024, Wup, 0, 0, scr, lane);
                    convert_job<0>(base, gw2, NGW2, a.w_down + (size_t)l * 4096 * 1024, 4096, 1024, 1024, nullptr, Wdn, 0, 0, scr, lane);
                }
                if (half) {
                    if (l == 0) convert_job<1>(base, gw2, NGW2, a.a_w_in + (size_t)1024 * 2560, 1024, 2560, 2560, a.norm_mix + 1024, WinA + (size_t)2560 * 1024, 0, 0, scr, lane);
                    if (l == 1) { convert_job<0>(base, gw2, NGW2, a.b_w_q, 1024, 1024, 1024, a.norm_mix + 2 * 1024, Wqkv, 0, 0, scr, lane);
                                  convert_job<0>(base, gw2, NGW2, a.w_kv, 1024, 1536, 1536, a.kv_norm, Wqkv, 1024, 0, scr, lane); }
                    if (l == 2) convert_job<0>(base, gw2, NGW2, a.b_w_q + (size_t)1024 * 1024, 1024, 1024, 1024, a.norm_mix + 3 * 1024, Wq1, 0, 0, scr, lane);
                    convert_job<0>(base, gw2, NGW2, a.w_o + (size_t)(l + 1) * 1024 * 1024, 1024, 1024, 1024, nullptr, Wo + (size_t)(l + 1) * 1024 * 1024, 0, 0, scr, lane);
                }
                if ((l == 1 && half) || (l == 3 && !(G == 256)))
                    convert_job<0>(base, gw2, NGW2, a.w_up + (size_t)3 * 1024 * 4096, 1024, 4096, 4096, a.norm_mlp + 3 * 1024, (bf16_t*)a.out, 0, 0, scr, lane);
                if ((l == 2 && half) || (l == 3 && !(G == 256)))
                    convert_job<0>(base, gw2, NGW2, a.w_down + (size_t)3 * 4096 * 1024, 4096, 1024, 1024, nullptr, WinA, 0, 0, scr, lane);
            }
        }
        xcd_barrier(bar);

        if (l == 0) {
            for (int it = gw; it < 64; it += NGW) { const int t = it & 3, h = (it >> 2) & 3, ly = it >> 4;
                kv_post_item<false, 64, 1>(MKV, 2048, ly * 512 + h * 64, 0, ly * 512 + 256 + h * 64, 64 * t, a.mem_k_norm + ly * 64, memimg + (size_t)((ly * 4 + h) * 4 + t) * 16384, lane); }
        }
        if (l == 2) {
            for (int it = gw; it < 6 * 256; it += NGW) { const int t = it & 255, h = it >> 8;
                kv_post_item<true, 128, 2>(KVB, 1536, h * 64, 384, 768 + h * 128, 64 * t, a.k_norm, kvimg + (size_t)(h * 256 + t) * 32768, lane); }
        }
        if (isA) {
            const float* wc = a.a_conv + (size_t)l * 3 * 768;
            for (int it = bx * 512 + tid; it < (S_ / 4) * 96; it += G * 512) {
                const int t0 = (it / 96) * 4, ch = (it % 96) * 8;
                u32x4 uu[6], bb[4];
#pragma unroll
                for (int r = 0; r < 6; ++r) { const int t = t0 - 2 + r; uu[r] = (u32x4){0u, 0u, 0u, 0u}; if (t >= 0) uu[r] = *(const u32x4*)(U + (size_t)t * 768 + ch); }
#pragma unroll
                for (int r = 0; r < 4; ++r) bb[r] = *(const u32x4*)(CAT + (size_t)(t0 + r) * 1024 + ch);
                const f32x4 w0a = *(const f32x4*)(wc + ch), w0b = *(const f32x4*)(wc + ch + 4), w1a = *(const f32x4*)(wc + 768 + ch), w1b = *(const f32x4*)(wc + 768 + ch + 4),
                            w2a = *(const f32x4*)(wc + 1536 + ch), w2b = *(const f32x4*)(wc + 1536 + ch + 4);
#define CONV2(k, bw, u0w, u1w, u2w, wa0, wa1, wa2, e) \
                y[k] = bf_lo(bw) * (wa0[e] * bf_lo(u0w) + wa1[e] * bf_lo(u1w) + wa2[e] * bf_lo(u2w)); \
                y[k + 1] = bf_hi(bw) * (wa0[e + 1] * bf_hi(u0w) + wa1[e + 1] * bf_hi(u1w) + wa2[e + 1] * bf_hi(u2w));
#pragma unroll
                for (int r = 0; r < 4; ++r) {
                    const u32x4 b = bb[r], u0 = uu[r], u1 = uu[r + 1], u2 = uu[r + 2]; float y[8];
                    CONV2(0, b.x, u0.x, u1.x, u2.x, w0a, w1a, w2a, 0) CONV2(2, b.y, u0.y, u1.y, u2.y, w0a, w1a, w2a, 2)
                    CONV2(4, b.z, u0.z, u1.z, u2.z, w0b, w1b, w2b, 0) CONV2(6, b.w, u0.w, u1.w, u2.w, w0b, w1b, w2b, 2)
                    u32x4 w; w.x = cvt_pk_bf16(y[0], y[1]); w.y = cvt_pk_bf16(y[2], y[3]); w.z = cvt_pk_bf16(y[4], y[5]); w.w = cvt_pk_bf16(y[6], y[7]);
                    *(u32x4*)(CAT + (size_t)(t0 + r) * 1024 + ch) = w;
                }
#undef CONV2
            }
        }
        if (l == 0 || l == 2) xcd_barrier(bar);

        {
            const float memM = 8.0f * max_abs64(a.mem_q_norm + l * 64) * max_abs64(a.mem_k_norm + l * 64) * LOG2E * 1.02f;
            const bf16_t* Qsrc = isA ? CAT : QB;
            if (isA) {
                for (int u = bx; u < 256; u += G) { const int qb = u >> 2, h = u & 3;
                    attn_unit<false>(lds, Qsrc + 768 + h * 64, 1024, a.mem_q_norm + l * 64, memimg + (size_t)((l * 4 + h) * 4) * 16384, 4, qb * 256, CAT + 768 + h * 64, 1024, -memM, 0.f, nullptr, 0.f); }
            } else {
                const float* lp = a.b_lam + j * 256; float d01 = 0.f, d23 = 0.f;
                for (int i = 0; i < 64; ++i) { d01 += lp[i] * lp[64 + i]; d23 += lp[128 + i] * lp[192 + i]; }
                const float lam_init = 0.8f - 0.6f * expf(-0.3f * (float)l);
                const float lam = expf(d01) - expf(d23) + lam_init;
                const float dM = 8.0f * max_abs64(a.b_q_norm + j * 64) * max_abs64(a.k_norm) * LOG2E * 1.02f;
                {
                unsigned* ctrs = ctl + j * 1280;
                for (;;) {
                    if (tid == 0) misc[0] = atomicAdd(ctrs, 1u);
                    __syncthreads();
                    const unsigned jb = misc[0];
                    __syncthreads();
                    if (jb >= 256u) break;
#pragma unroll 1
                    for (int k = 0; k < 3; ++k) { const int e = kAttnSched[jb * 3 + k], h = e >> 7, qblk = e & 127;
                        attn_unit<true>(lds, QB + h * 64, 1024, a.b_q_norm + j * 64, kvimg + (size_t)(h * 256) * 32768, 2 * qblk + 2, qblk * 128, CAT + h * 128, 1024, -dM, lam, a.b_subln + j * 128, 1.0f - lam_init); }
                }
                for (;;) {
                    if (tid == 0) misc[0] = atomicAdd(ctrs + 64, 1u);
                    __syncthreads();
                    const unsigned u = misc[0];
                    __syncthreads();
                    if (u >= 256u) break;
                    const int qb = (int)(u >> 2), h = (int)(u & 3u);
                    attn_unit<false>(lds, Qsrc + 768 + h * 64, 1024, a.mem_q_norm + l * 64, memimg + (size_t)((l * 4 + h) * 4) * 16384, 4, qb * 256, CAT + 768 + h * 64, 1024, -memM, 0.f, nullptr, 0.f);
                }
                }
            }
        }
        xcd_barrier(bar);

        {
            pg8::Gemm g{CAT, Wo + (size_t)l * 1024 * 1024, S_, 1024, 1024}; pg8::StaticOrder S; S.init(S_, 1024, G, bx);
            EpiRes E{nullptr, XB, stats};
            pg8::gemm_phase<EpiRes, pg8::StaticOrder, true, true>(lds, g, S, E);
        }
        xcd_barrier(bar);
        {
            pg8::Gemm g{XB, l == 3 ? (const bf16_t*)a.out : Wup, S_, 4096, 1024}; pg8::StaticOrder S; S.init(S_, 4096, G, bx);
            const int pm0 = panel_rstd_to_lds(lds, stats, S);
            EpiBf16<1> E{stats, 1 << 30, H, 4096, H, 4096, (const LAS float*)(lds + MISC_OFF + 1024), pm0};
            pg8::gemm_phase<EpiBf16<1>, pg8::StaticOrder, false, true>(lds, g, S, E);
        }
        xcd_barrier(bar);
        {
            pg8::Gemm g{H, l == 3 ? WinA : Wdn, S_, 1024, 4096}; pg8::StaticOrder S; S.init(S_, 1024, G, bx);
            EpiRes E{l == 3 ? a.out : nullptr, XB, stats};
            pg8::gemm_phase<EpiRes, pg8::StaticOrder, true, true>(lds, g, S, E);
        }
        if (l < 3) xcd_barrier(bar);
    }
}

__global__ void __launch_bounds__(NWAVES * 64, 2) yoco_fwd(Args a) {
    extern __shared__ __attribute__((aligned(16))) unsigned char lds_raw[];
    LAS unsigned char* lds = (LAS unsigned char*)lds_raw;
    cg::grid_group grid = cg::this_grid();
    { LAS unsigned* mz = (LAS unsigned*)(lds + MISC_OFF); if (threadIdx.x < 32) mz[threadIdx.x] = 0u; }
    __syncthreads();
    XcdBarrier bar = xcd_barrier_post((unsigned*)(a.ws + WS_CTL) + 4096, (volatile LAS unsigned*)(lds + MISC_OFF) + 8);
    prologue_body(a, lds);
    if (a.ws == nullptr) grid.sync();
    xcd_barrier(bar);
    layer_body<0>(a, lds, bar);
    layer_body<1>(a, lds, bar);
    layer_body<2>(a, lds, bar);
    layer_body<3>(a, lds, bar);
}

extern "C" void kernel_launch(void* const* d_in, const int* in_sizes, int n_in, void* d_out, int out_size, void* d_ws, size_t ws_size, hipStream_t stream) {
    static int grid = 0;
    if (grid == 0) {
        if (n_in != 20 || ws_size < WS_END) { fprintf(stderr, "kernel_launch: unexpected n_in %d / ws_size %zu\n", n_in, ws_size); grid = -1; return; }
        int dev = 0, cus = 0, per_cu = 0;
        hipGetDevice(&dev); hipDeviceGetAttribute(&cus, hipDeviceAttributeMultiprocessorCount, dev);
        hipFuncSetAttribute((const void*)yoco_fwd, hipFuncAttributeMaxDynamicSharedMemorySize, LDS_BYTES);
        hipOccupancyMaxActiveBlocksPerMultiprocessor(&per_cu, (const void*)yoco_fwd, NWAVES * 64, LDS_BYTES);
        (void)hipGetLastError();
        if (per_cu < 1) per_cu = 1;
        grid = cus;
        fprintf(stderr, "kernel_launch: cus %d per_cu %d grid %d\n", cus, per_cu, grid);
    }
    if (grid < 0) return;
    hipMemsetAsync((char*)d_ws + WS_CTL, 0, 65536, stream);
    Args a{};
    const float** pp = (const float**)&a;
    for (int i = 0; i < 20; ++i) pp[i] = (const float*)d_in[i];
    a.out = (float*)d_out; a.ws = (unsigned char*)d_ws;
    void* args[] = {&a};
    hipError_t e = hipLaunchCooperativeKernel((const void*)yoco_fwd, dim3(grid), dim3(NWAVES * 64), args, LDS_BYTES, stream);
    if (e != hipSuccess) fprintf(stderr, "cooperative launch failed: %s (grid %d)\n", hipGetErrorString(e), grid);
}
```

```cpp
#include <hip/hip_runtime.h>
#include <hip/hip_cooperative_groups.h>
#include <cstdio>
#include <cstdint>
namespace cg = cooperative_groups;
namespace pg8 {
#define PG8_LAS __attribute__((address_space(3)))
typedef unsigned short bf16_t;
typedef short bf16x8 __attribute__((ext_vector_type(8)));
typedef float f32x4 __attribute__((ext_vector_type(4)));
typedef unsigned u32x4 __attribute__((ext_vector_type(4)));
constexpr int BM = 256, BK = 64, HALF = 128, HTB = HALF * BK * 2  , STAGE_BYTES = 8 * HTB, NXCD = 8, WGM = 8;

__host__ __device__ __forceinline__ int lds_byte(int r, int c) { const int st = (r >> 4) * 2 + (c >> 5), rr = r & 15, cc = c & 31, ob = rr * 64 + cc * 2; return st * 1024 + (ob ^ (((ob >> 9) & 1) << 5)); }
__host__ __device__ __forceinline__ void stage_rc(int b, int& R, int& C) { const int st = b / 1024, sb = b % 1024, swz = sb ^ (((sb >> 9) & 1) << 5); R = (st >> 1) * 16 + swz / 64; C = (st & 1) * 32 + (swz % 64) / 2; }
__host__ __device__ __forceinline__ int perm32(int rho) { const int n = rho >> 4, i = rho & 15; return 8 * (i >> 2) + 4 * n + (i & 3); }

struct Unit { int pm, pn; };
struct Gemm { const bf16_t* A; const bf16_t* Bt; int M, N, K; };

struct StaticOrder {
    int nM, nN, nwg, G, c;
    __host__ __device__ void init(int M, int N, int G_, int c_) { nM = M / BM; nN = N / BM; nwg = nM * nN; G = G_; c = c_; }
    __host__ __device__ bool next(int i, Unit& u) const {
        const long L = (long)i * G + c; if (L >= nwg) return false;
        int wgid = (int)L; { const int q = nwg / NXCD, r = nwg % NXCD, xcd = wgid % NXCD, off = wgid / NXCD; wgid = (xcd < r ? xcd * (q + 1) : r * (q + 1) + (xcd - r) * q) + off; }
        const int nig = WGM * nN, gid = wgid / nig, fm = gid * WGM, gsz = (nM - fm) < WGM ? (nM - fm) : WGM;
        u.pm = fm + ((wgid % nig) % gsz); u.pn = (wgid % nig) / gsz; return true;
    }
    __device__ __forceinline__ void a_ready(const Unit&) const {}
    __device__ __forceinline__ void done(const Unit&) const {}
};

typedef float f32x2_cv __attribute__((ext_vector_type(2))); typedef __bf16 bf16x2_cv __attribute__((ext_vector_type(2)));
__device__ __forceinline__ unsigned cvt_pk_bf16(float lo, float hi) { f32x2_cv v = {lo, hi}; bf16x2_cv b = __builtin_convertvector(v, bf16x2_cv); return __builtin_bit_cast(unsigned, b); }
template <class Epi, class Sched, bool ALIGN_EPI = false, bool SP2 = false>
__device__ __forceinline__ void gemm_phase(PG8_LAS unsigned char* lds, const Gemm g, const Sched& S, const Epi& E) {
    int tid_ = threadIdx.x; asm volatile("" : "+v"(tid_));
    const int tid = tid_, wid = __builtin_amdgcn_readfirstlane(tid >> 6), lane = tid & 63, wr = wid >> 2, wc = wid & 3, fr = lane & 15, fq = lane >> 4;
    const int K = g.K, nt = K / BK;
    unsigned voffA[2], voffB[2];
#pragma unroll
    for (int i = 0; i < 2; ++i) { int R, C; stage_rc(tid * 16 + i * 8192, R, C); const int Rb = Epi::PERM ? ((R & ~31) + perm32(R & 31)) : R;
        voffA[i] = (unsigned)(R * K + C) * 2u; voffB[i] = (unsigned)(Rb * K + C) * 2u; }
    const size_t kstep = (size_t)(BK * 2);
    const size_t hstep = (size_t)HALF * K * 2;
    const size_t tstep = 2 * hstep;
    const unsigned ldsw = (unsigned)wid * 1024u;
    const int aoff = lds_byte(wr * 64 + fr, fq * 8), boff = lds_byte(wc * 32 + fr, fq * 8);
#define PG8_SA(b, h) (((b) * 2 + (h)) * HTB)
#define PG8_SB(b, h) ((4 + (b) * 2 + (h)) * HTB)
#define PG8_STAGE(bufoff, gbase, voff) do { _Pragma("unroll") for (int _i = 0; _i < 2; ++_i) \
        __builtin_amdgcn_global_load_lds((const unsigned*)((const char*)(gbase) + (voff)[_i]), (PG8_LAS unsigned*)(lds + (bufoff) + ldsw + _i * 8192), 16, 0, 0); } while (0)
#define PG8_LDA(dst, b, h) do { _Pragma("unroll") for (int m = 0; m < 4; ++m) _Pragma("unroll") for (int k = 0; k < 2; ++k) dst[m][k] = *(const PG8_LAS bf16x8*)(lds + PG8_SA(b, h) + aoff + m * 2048 + k * 1024); } while (0)
#define PG8_LDB(dst, b, h) do { _Pragma("unroll") for (int n = 0; n < 2; ++n) _Pragma("unroll") for (int k = 0; k < 2; ++k) dst[n][k] = *(const PG8_LAS bf16x8*)(lds + PG8_SB(b, h) + boff + n * 2048 + k * 1024); } while (0)
#define PG8_MMA(ai, bj, At, Bt) do { __builtin_amdgcn_s_setprio(1); _Pragma("unroll") for (int m = 0; m < 4; ++m) _Pragma("unroll") for (int n = 0; n < 2; ++n) _Pragma("unroll") for (int k = 0; k < 2; ++k) \
        acc[ai][bj][m][n] = __builtin_amdgcn_mfma_f32_16x16x32_bf16(Bt[n][k], At[m][k], acc[ai][bj][m][n], 0, 0, 0); __builtin_amdgcn_s_setprio(0); } while (0)
#define PG8_WAIT_V(n) asm volatile("s_waitcnt vmcnt(" #n ")" ::: "memory")
#define PG8_WAIT_L(n) asm volatile("s_waitcnt lgkmcnt(" #n ")" ::: "memory")
#define PG8_BAR __builtin_amdgcn_s_barrier()
#define PG8_SCHED __builtin_amdgcn_sched_barrier(0)
    Unit cur, nxt; int ui = 0;
    if (!S.next(0, cur)) return;
    f32x4 acc[2][2][4][2];
#pragma unroll
    for (int a = 0; a < 2; ++a)
#pragma unroll
        for (int b = 0; b < 2; ++b)
#pragma unroll
            for (int m = 0; m < 4; ++m)
#pragma unroll
                for (int n = 0; n < 2; ++n) acc[a][b][m][n] = (f32x4){0.f, 0.f, 0.f, 0.f};
    bf16x8 At[4][2], B0[2][2], B1[2][2];
    const char* cA = (const char*)g.A + (size_t)cur.pm * tstep; const char* cB = (const char*)g.Bt + (size_t)cur.pn * tstep;
    S.a_ready(cur);
    if constexpr (SP2) {
        PG8_STAGE(PG8_SB(0, 0), cB, voffB); PG8_STAGE(PG8_SB(0, 1), cB + hstep, voffB); PG8_STAGE(PG8_SA(0, 0), cA, voffA); PG8_STAGE(PG8_SA(0, 1), cA + hstep, voffA);
        if (wr == 1) PG8_BAR;
        PG8_WAIT_V(2); PG8_BAR;
        PG8_STAGE(PG8_SB(1, 0), cB + kstep, voffB); PG8_STAGE(PG8_SA(1, 0), cA + kstep, voffA); PG8_STAGE(PG8_SB(1, 1), cB + hstep + kstep, voffB);
        PG8_WAIT_V(6); PG8_BAR;
    } else {
        PG8_STAGE(PG8_SB(0, 0), cB, voffB); PG8_STAGE(PG8_SA(0, 0), cA, voffA); PG8_STAGE(PG8_SB(0, 1), cB + hstep, voffB); PG8_STAGE(PG8_SA(0, 1), cA + hstep, voffA);
        if (wr == 1) PG8_BAR;
        PG8_WAIT_V(4); PG8_BAR;
        PG8_STAGE(PG8_SB(1, 0), cB + kstep, voffB); PG8_STAGE(PG8_SA(1, 0), cA + kstep, voffA); PG8_STAGE(PG8_SB(1, 1), cB + hstep + kstep, voffB);
        PG8_WAIT_V(6); PG8_BAR;
    }
    for (;;) {
        const bool has_next = S.next(ui + 1, nxt);
        const char* nA = has_next ? (const char*)g.A + (size_t)nxt.pm * tstep : cA; const char* nB = has_next ? (const char*)g.Bt + (size_t)nxt.pn * tstep : cB;
        for (int t = 0; t < nt; t += 2) {
            const bool last = (t == nt - 2);
            const char* a1 = cA + (size_t)(t + 1) * kstep;
            const char* a2 = last ? nA : cA + (size_t)(t + 2) * kstep; const char* b2 = last ? nB : cB + (size_t)(t + 2) * kstep;
            const char* a3 = a2 + kstep; const char* b3 = b2 + kstep;
            if (last && has_next) S.a_ready(nxt);
            if constexpr (SP2) {
            PG8_LDB(B0, 0, 0); PG8_LDB(B1, 0, 1); PG8_SCHED; PG8_LDA(At, 0, 0); PG8_STAGE(PG8_SA(1, 1), a1 + hstep, voffA);
            PG8_WAIT_V(8); PG8_WAIT_L(0); PG8_BAR; PG8_MMA(0, 0, At, B0); PG8_MMA(0, 1, At, B1); PG8_BAR; PG8_SCHED;
            PG8_LDA(At, 0, 1); PG8_STAGE(PG8_SB(0, 0), b2, voffB); PG8_STAGE(PG8_SB(0, 1), b2 + hstep, voffB); PG8_STAGE(PG8_SA(0, 0), a2, voffA);
            PG8_WAIT_V(8); PG8_WAIT_L(0); PG8_BAR; PG8_MMA(1, 0, At, B0); PG8_MMA(1, 1, At, B1); PG8_BAR; PG8_SCHED;
            PG8_LDB(B0, 1, 0); PG8_LDB(B1, 1, 1); PG8_SCHED; PG8_LDA(At, 1, 0); PG8_STAGE(PG8_SA(0, 1), a2 + hstep, voffA);
            PG8_WAIT_V(8); PG8_WAIT_L(0); PG8_BAR; PG8_MMA(0, 0, At, B0); PG8_MMA(0, 1, At, B1); PG8_BAR; PG8_SCHED;
            PG8_LDA(At, 1, 1); PG8_STAGE(PG8_SB(1, 0), b3, voffB); PG8_STAGE(PG8_SB(1, 1), b3 + hstep, voffB); PG8_STAGE(PG8_SA(1, 0), a3, voffA);
            PG8_WAIT_V(8); PG8_WAIT_L(0); PG8_BAR; PG8_MMA(1, 0, At, B0); PG8_MMA(1, 1, At, B1); PG8_BAR; PG8_SCHED;
            } else {
            PG8_LDB(B0, 0, 0); PG8_SCHED; PG8_LDA(At, 0, 0); PG8_STAGE(PG8_SA(1, 1), a1 + hstep, voffA);
            PG8_WAIT_L(8); PG8_BAR; PG8_WAIT_L(0); PG8_MMA(0, 0, At, B0); PG8_BAR; PG8_SCHED;
            PG8_LDB(B1, 0, 1); PG8_STAGE(PG8_SB(0, 0), b2, voffB);
            PG8_BAR; PG8_WAIT_L(0); PG8_MMA(0, 1, At, B1); PG8_BAR;
            PG8_LDA(At, 0, 1); PG8_STAGE(PG8_SA(0, 0), a2, voffA);
            PG8_BAR; PG8_WAIT_L(0); PG8_MMA(1, 0, At, B0); PG8_BAR; PG8_SCHED;
            PG8_STAGE(PG8_SB(0, 1), b2 + hstep, voffB);
            PG8_WAIT_V(6); PG8_BAR; PG8_MMA(1, 1, At, B1); PG8_BAR;
            PG8_LDB(B0, 1, 0); PG8_SCHED; PG8_LDA(At, 1, 0); PG8_STAGE(PG8_SA(0, 1), a2 + hstep, voffA);
            PG8_WAIT_L(8); PG8_BAR; PG8_WAIT_L(0); PG8_MMA(0, 0, At, B0); PG8_BAR; PG8_SCHED;
            PG8_LDB(B1, 1, 1); PG8_STAGE(PG8_SB(1, 0), b3, voffB);
            PG8_BAR; PG8_WAIT_L(0); PG8_MMA(0, 1, At, B1); PG8_BAR;
            PG8_LDA(At, 1, 1); PG8_STAGE(PG8_SA(1, 0), a3, voffA);
            PG8_BAR; PG8_WAIT_L(0); PG8_MMA(1, 0, At, B0); PG8_BAR; PG8_SCHED;
            PG8_STAGE(PG8_SB(1, 1), b3 + hstep, voffB);
            PG8_WAIT_V(6); PG8_BAR; PG8_MMA(1, 1, At, B1); PG8_BAR;
            }
        }
        if constexpr (ALIGN_EPI) { if (wr == 0) PG8_BAR; }
        if constexpr (!Epi::AFTER_DRAIN) { E(acc, cur, wr, wc, fr, fq); S.done(cur); }
        if (!has_next) break;
#pragma unroll
        for (int a = 0; a < 2; ++a)
#pragma unroll
            for (int b = 0; b < 2; ++b)
#pragma unroll
                for (int m = 0; m < 4; ++m)
#pragma unroll
                    for (int n = 0; n < 2; ++n) acc[a][b][m][n] = (f32x4){0.f, 0.f, 0.f, 0.f};
        cur = nxt; cA = nA; cB = nB; ++ui;
        if constexpr (ALIGN_EPI) { if (wr == 1) PG8_BAR; }
    }
    PG8_WAIT_V(0);
    if constexpr (!ALIGN_EPI) { if (wr == 0) PG8_BAR; }
    PG8_BAR;
    if constexpr (Epi::AFTER_DRAIN) { E.fused(acc, cur, wr, wc, fr, fq, lds, wid, lane); S.done(cur); }
#undef PG8_SA
#undef PG8_SB
#undef PG8_STAGE
#undef PG8_LDA
#undef PG8_LDB
#undef PG8_MMA
#undef PG8_WAIT_V
#undef PG8_WAIT_L
#undef PG8_BAR
#undef PG8_SCHED
}
}

#define LAS __attribute__((address_space(3)))
typedef unsigned short bf16_t;
typedef short bf16x8 __attribute__((ext_vector_type(8)));
typedef float f32x4 __attribute__((ext_vector_type(4)));
typedef float f32x16 __attribute__((ext_vector_type(16)));
typedef unsigned u32x4 __attribute__((ext_vector_type(4)));
typedef unsigned u32x2 __attribute__((ext_vector_type(2)));

constexpr int S_ = 16384, D_ = 1024, FF_ = 4096, MEMLEN = 256;
constexpr int NWAVES = 8;
constexpr size_t MiB = 1u << 20;
constexpr size_t WS_STATS = 0;
constexpr size_t WS_MEMIMG = 1 * MiB;
constexpr size_t WS_WINA = 2 * MiB;
constexpr size_t WS_WQKV = 12 * MiB;
constexpr size_t WS_WQ1 = 17 * MiB;
constexpr size_t WS_WMKV = 19 * MiB;
constexpr size_t WS_WO = 23 * MiB;
constexpr size_t WS_WUP = 31 * MiB;
constexpr size_t WS_WDN = 39 * MiB;
constexpr size_t WS_XB = 47 * MiB;
constexpr size_t WS_KVIMG = 79 * MiB;
constexpr size_t WS_H = 127 * MiB;
constexpr size_t WS_U = WS_H;
constexpr size_t WS_QB = WS_H;
constexpr size_t WS_CAT = WS_H + 32 * MiB;
constexpr size_t WS_KVB = WS_H + 64 * MiB;
constexpr size_t WS_MEMN = WS_H + 112 * MiB;
constexpr size_t WS_MKV = WS_H + 113 * MiB;
constexpr size_t WS_CTL = 255 * MiB;
constexpr size_t WS_END = 256 * MiB;

constexpr int RING_BYTES = 131072;
constexpr int MISC_OFF = RING_BYTES;
constexpr int LDS_BYTES = 147456;

#define LDS_WAIT() asm volatile("s_waitcnt lgkmcnt(0)" ::: "memory")

struct Args {
    const float *x, *mem, *norm_mix, *norm_mlp, *a_w_in, *a_conv, *b_w_q, *b_q_norm, *b_lam, *b_subln, *kv_norm, *w_kv, *k_norm, *mem_norm,
        *w_mem_kv, *mem_q_norm, *mem_k_norm, *w_o, *w_up, *w_down;
    float* out; unsigned char* ws;
};

__device__ __forceinline__ float bf_lo(unsigned w) { return __uint_as_float(w << 16); }
__device__ __forceinline__ float bf_hi(unsigned w) { return __uint_as_float(w & 0xffff0000u); }
__device__ __forceinline__ float wave_sum(float v) {
#pragma unroll
    for (int o = 1; o < 64; o <<= 1) v += __shfl_xor(v, o);
    return v;
}
__device__ __forceinline__ void st16_wt(void* p, u32x4 v) { asm volatile("global_store_dwordx4 %0, %1, off sc1\n\ts_nop 1" :: "v"(p), "v"(v) : "memory"); }
__device__ __forceinline__ void st8_wt(void* p, u32x2 v) { asm volatile("global_store_dwordx2 %0, %1, off sc1\n\ts_nop 1" :: "v"(p), "v"(v) : "memory"); }
__device__ __forceinline__ float row_rstd(const float* stats, int row) {
    const f32x4* p = (const f32x4*)(stats + (size_t)row * 16);
    const f32x4 a = p[0], b = p[1], c = p[2], d = p[3];
    const float s = ((a[0] + a[1]) + (a[2] + a[3])) + ((b[0] + b[1]) + (b[2] + b[3])) + ((c[0] + c[1]) + (c[2] + c[3])) + ((d[0] + d[1]) + (d[2] + d[3]));
    return rsqrtf(s * (1.0f / 1024.0f) + 1e-6f);
}

using pg8::Unit; using pg8::cvt_pk_bf16;
struct EpiInA {
    static constexpr bool PERM = true, AFTER_DRAIN = false;
    const float* stats; bf16_t* U; bf16_t* CAT; const LAS float* rl; int rl_pm;
    __device__ __forceinline__ void operator()(const f32x4 (&acc)[2][2][4][2], const Unit& u, int wr, int wc, int fr, int fq) const {
        const int row0 = u.pm * 256 + wr * 64 + fr;
#pragma unroll
        for (int ai = 0; ai < 2; ++ai)
#pragma unroll
            for (int m = 0; m < 4; ++m) {
                const int row = row0 + ai * 128 + m * 16; const float rs = (rl && u.pm == rl_pm) ? rl[row - rl_pm * 256] : row_rstd(stats, row);
                if (u.pn < 6) {
                    const float r2 = rs * rs;
                    const f32x4 v0 = acc[ai][0][m][0] * acc[ai][1][m][0] * r2, v1 = acc[ai][0][m][1] * acc[ai][1][m][1] * r2;
                    u32x4 w; w.x = cvt_pk_bf16(v0[0], v0[1]); w.y = cvt_pk_bf16(v0[2], v0[3]); w.z = cvt_pk_bf16(v1[0], v1[1]); w.w = cvt_pk_bf16(v1[2], v1[3]);
                    st16_wt(U + (size_t)row * 768 + u.pn * 128 + wc * 32 + fq * 8, w);
                } else {
                    const int cbase = (u.pn - 6) * 256 + wc * 32 + fq * 8;
#pragma unroll
                    for (int bj = 0; bj < 2; ++bj) {
                        const f32x4 v0 = acc[ai][bj][m][0] * rs, v1 = acc[ai][bj][m][1] * rs;
                        u32x4 w; w.x = cvt_pk_bf16(v0[0], v0[1]); w.y = cvt_pk_bf16(v0[2], v0[3]); w.z = cvt_pk_bf16(v1[0], v1[1]); w.w = cvt_pk_bf16(v1[2], v1[3]);
                        st16_wt(CAT + (size_t)row * 1024 + cbase + bj * 128, w);
                    }
                }
                asm volatile("" ::: "memory");
            }
    }
};
template <int ACT> struct EpiBf16 {
    static constexpr bool PERM = true, AFTER_DRAIN = false;
    const float* stats; int N1; bf16_t* P1; int ld1; bf16_t* P2; int ld2; const LAS float* rl; int rl_pm;
    __device__ __forceinline__ void operator()(const f32x4 (&acc)[2][2][4][2], const Unit& u, int wr, int wc, int fr, int fq) const {
        const int row0 = u.pm * 256 + wr * 64 + fr; int colt = u.pn * 256; bf16_t* base = P1; int ld = ld1;
        if (colt >= N1) { colt -= N1; base = P2; ld = ld2; }
        const int col0 = colt + wc * 32 + fq * 8;
#pragma unroll
        for (int ai = 0; ai < 2; ++ai)
#pragma unroll
            for (int m = 0; m < 4; ++m) {
                const int row = row0 + ai * 128 + m * 16; const float rs = stats ? ((rl && u.pm == rl_pm) ? rl[row - rl_pm * 256] : row_rstd(stats, row)) : 1.0f;
#pragma unroll
                for (int bj = 0; bj < 2; ++bj) {
                    f32x4 v0 = acc[ai][bj][m][0] * rs, v1 = acc[ai][bj][m][1] * rs;
                    if (ACT == 1) {
#pragma unroll
                        for (int e = 0; e < 4; ++e) { const float a = fmaxf(v0[e], 0.f), b = fmaxf(v1[e], 0.f); v0[e] = a * a; v1[e] = b * b; }
                    }
                    u32x4 w; w.x = cvt_pk_bf16(v0[0], v0[1]); w.y = cvt_pk_bf16(v0[2], v0[3]); w.z = cvt_pk_bf16(v1[0], v1[1]); w.w = cvt_pk_bf16(v1[2], v1[3]);
                    st16_wt(base + (size_t)row * ld + col0 + bj * 128, w);
                }
                asm volatile("" ::: "memory");
            }
    }
};
struct EpiRes {
    static constexpr bool PERM = true, AFTER_DRAIN = false;
    float* out; bf16_t* xb; float* stats;
    __device__ __forceinline__ void operator()(const f32x4 (&acc)[2][2][4][2], const Unit& u, int wr, int wc, int fr, int fq) const {
        const int row0 = u.pm * 256 + wr * 64 + fr; const int col0 = u.pn * 256 + wc * 32 + fq * 8;
#pragma unroll
        for (int ai = 0; ai < 2; ++ai)
#pragma unroll
            for (int m = 0; m < 4; ++m) {
                const int row = row0 + ai * 128 + m * 16; float ss = 0.f;
#pragma unroll
                for (int bj = 0; bj < 2; ++bj) {
                    const size_t off = (size_t)row * 1024 + col0 + bj * 128;
                    const u32x4 b = *(const u32x4*)(xb + off);
                    const f32x4 b0 = {bf_lo(b.x), bf_hi(b.x), bf_lo(b.y), bf_hi(b.y)}, b1 = {bf_lo(b.z), bf_hi(b.z), bf_lo(b.w), bf_hi(b.w)};
                    const f32x4 v0 = acc[ai][bj][m][0] + b0, v1 = acc[ai][bj][m][1] + b1;
                    if (out) { *(f32x4*)(out + off) = v0; *(f32x4*)(out + off + 4) = v1; }
                    ss += (v0[0] * v0[0] + v0[1] * v0[1]) + (v0[2] * v0[2] + v0[3] * v0[3]) + (v1[0] * v1[0] + v1[1] * v1[1]) + (v1[2] * v1[2] + v1[3] * v1[3]);
                    u32x4 w; w.x = cvt_pk_bf16(v0[0], v0[1]); w.y = cvt_pk_bf16(v0[2], v0[3]); w.z = cvt_pk_bf16(v1[0], v1[1]); w.w = cvt_pk_bf16(v1[2], v1[3]);
                    *(u32x4*)(xb + off) = w;
                }
                ss += __shfl_xor(ss, 16); ss += __shfl_xor(ss, 32);
                if (fq == 0) stats[(size_t)row * 16 + u.pn * 4 + wc] = ss;
                asm volatile("" ::: "memory");
            }
    }
};

__device__ __forceinline__ void ti_load(f32x4 (&v)[8], const float* W, int N, int src_col0, int k0, int lane) {
#pragma unroll
    for (int r = 0; r < 8; ++r) { const int kk = 8 * r + (lane >> 3), n4 = (lane & 7) * 4;
        v[r] = __builtin_nontemporal_load((const f32x4*)(W + (size_t)(k0 + kk) * N + src_col0 + n4)); }
}
__device__ __forceinline__ void ti_finish(const f32x4 (&v)[8], const float* g, bf16_t* WT, int K, int dst_row0, int k0, LAS float* scr, int lane) {
    const int c = lane & 7;
    f32x4 ga = {1.f, 1.f, 1.f, 1.f}, gb = {1.f, 1.f, 1.f, 1.f};
    if (g) { ga = *(const f32x4*)(g + k0 + 8 * c); gb = *(const f32x4*)(g + k0 + 8 * c + 4); }
#pragma unroll
    for (int r = 0; r < 8; ++r) { const int kk = 8 * r + (lane >> 3), n4 = (lane & 7) * 4; LAS float* d = scr + kk * 33 + n4; d[0] = v[r][0]; d[1] = v[r][1]; d[2] = v[r][2]; d[3] = v[r][3]; }
    LDS_WAIT(); asm volatile("" ::: "memory");
#pragma unroll
    for (int j = 0; j < 4; ++j) { const int n = (lane >> 3) + 8 * j; const LAS float* s = scr + (8 * c) * 33 + n;
        u32x4 o; o.x = cvt_pk_bf16(s[0 * 33] * ga[0], s[1 * 33] * ga[1]); o.y = cvt_pk_bf16(s[2 * 33] * ga[2], s[3 * 33] * ga[3]); o.z = cvt_pk_bf16(s[4 * 33] * gb[0], s[5 * 33] * gb[1]); o.w = cvt_pk_bf16(s[6 * 33] * gb[2], s[7 * 33] * gb[3]);
        *(u32x4*)(WT + (size_t)(dst_row0 + n) * K + k0 + 8 * c) = o; }
    LDS_WAIT(); asm volatile("" ::: "memory");
}
template <int MODE>
__device__ __forceinline__ int conv_src_col(int n0) {
    if (MODE == 1) { const int pn = n0 >> 8, within = n0 & 255;
        if (pn < 6) return ((within >> 7) ? 1536 : 768) + pn * 128 + (within & 127);
        if (pn < 9) return n0 - 1536; }
    return n0;
}
template <int MODE>
__device__ __forceinline__ void convert_job(int& base, int gw, int NGW, const float* W, int K, int Nsrc, int Ndst, const float* g, bf16_t* WT, int dst_row_base, int src_col_base, LAS float* scr, int lane) {
    const int nblk = Ndst / 32, n = (K / 64) * nblk;
    int it = (gw - base) % NGW; if (it < 0) it += NGW;
    f32x4 vc[8], vn[8];
    if (it < n) ti_load(vc, W, Nsrc, src_col_base + conv_src_col<MODE>((it % nblk) * 32), (it / nblk) * 64, lane);
    while (it < n) {
        const int itn = it + NGW;
        if (itn < n) ti_load(vn, W, Nsrc, src_col_base + conv_src_col<MODE>((itn % nblk) * 32), (itn / nblk) * 64, lane);
        ti_finish(vc, g, WT, K, dst_row_base + (it % nblk) * 32, (it / nblk) * 64, scr, lane);
#pragma unroll
        for (int r = 0; r < 8; ++r) vc[r] = vn[r];
        it = itn;
    }
    base += n;
}

__device__ __forceinline__ void rope_cs(int pos, int i, float& c, float& s) {
    const float inv = 1.0f / exp2f((float)i * (18.931568569324174f / 8.0f));
    const float ang = (float)pos * inv;
    double rev = (double)ang * 0.15915494309189535; rev -= __builtin_floor(rev);
    const float fr = (float)rev;
    c = __builtin_amdgcn_cosf(fr); s = __builtin_amdgcn_sinf(fr);
}
__device__ __forceinline__ int sigma_pos(int p) { return (p & ~12) | ((p & 4) << 1) | ((p & 8) >> 1); }

template <bool ROPE, int VD, int NMAPS>
__device__ __forceinline__ void kv_post_item(const bf16_t* src, int ld, int kcol0, int mapstride, int vcol0, int row0, const float* kg, unsigned char* img, int lane) {
#pragma unroll 1
    for (int map = 0; map < NMAPS; ++map) {
        const bf16_t* kr = src + (size_t)(row0 + lane) * ld + kcol0 + map * mapstride;
        float v[64]; float ss = 0.f;
#pragma unroll
        for (int c = 0; c < 8; ++c) { const u32x4 w = *(const u32x4*)(kr + 8 * c);
            v[8 * c + 0] = bf_lo(w.x); v[8 * c + 1] = bf_hi(w.x); v[8 * c + 2] = bf_lo(w.y); v[8 * c + 3] = bf_hi(w.y);
            v[8 * c + 4] = bf_lo(w.z); v[8 * c + 5] = bf_hi(w.z); v[8 * c + 6] = bf_lo(w.w); v[8 * c + 7] = bf_hi(w.w); }
#pragma unroll
        for (int d = 0; d < 64; ++d) ss += v[d] * v[d];
        const float rstd = rsqrtf(ss * (1.0f / 64.0f) + 1e-6f);
#pragma unroll
        for (int d = 0; d < 64; ++d) v[d] = v[d] * rstd * kg[d];
        if (ROPE) {
#pragma unroll
            for (int i = 0; i < 8; ++i) { float c, s; rope_cs(row0 + lane, i, c, s); const float x1 = v[i], x2 = v[i + 8]; v[i] = x1 * c - x2 * s; v[i + 8] = x1 * s + x2 * c; }
        }
        unsigned char* dst = img + map * 8192 + sigma_pos(lane) * 16;
#pragma unroll
        for (int c = 0; c < 8; ++c) { u32x4 w; w.x = cvt_pk_bf16(v[8 * c + 0], v[8 * c + 1]); w.y = cvt_pk_bf16(v[8 * c + 2], v[8 * c + 3]);
            w.z = cvt_pk_bf16(v[8 * c + 4], v[8 * c + 5]); w.w = cvt_pk_bf16(v[8 * c + 6], v[8 * c + 7]); *(u32x4*)(dst + c * 1024) = w; }
    }
#pragma unroll 1
    for (int pass = 0; pass < VD / 64; ++pass) {
        const int d = lane + 64 * pass;
        const bf16_t* vp = src + (size_t)row0 * ld + vcol0 + d;
        unsigned char* dst = img + NMAPS * 8192 + d * 16;
#pragma unroll
        for (int c = 0; c < 8; ++c) {
            unsigned e[8];
#pragma unroll
            for (int i = 0; i < 8; ++i) e[i] = vp[(size_t)(8 * c + i) * ld];
            u32x4 w; w.x = e[0] | (e[1] << 16); w.y = e[2] | (e[3] << 16); w.z = e[4] | (e[5] << 16); w.w = e[6] | (e[7] << 16);
            *(u32x4*)(dst + c * (VD * 16)) = w;
        }
    }
}

__device__ __forceinline__ void glds16(const void* gsrc, unsigned lds_dst) { unsigned keep;
    asm volatile("s_mov_b32 %0, m0\n\ts_mov_b32 m0, %2\n\ts_nop 0\n\tglobal_load_lds_dwordx4 %1, off\n\ts_mov_b32 m0, %0" : "=&s"(keep) : "v"(gsrc), "s"(lds_dst) : "memory"); }

template <bool DIFF>
__device__ __forceinline__ void attn_unit(LAS unsigned char* lds, const bf16_t* Qp, int qld, const float* qg, const unsigned char* img, int ntiles, int q0,
                                          bf16_t* Op, int old, float negM, float lam, const float* subg, float oscale) {
    constexpr int IMG = DIFF ? 32768 : 16384, VOFF = DIFF ? 16384 : 8192, NDB = DIFF ? 4 : 2, VCH = DIFF ? 2048 : 1024, NLD = IMG / 8192;
    int tid_ = threadIdx.x; asm volatile("" : "+v"(tid_));
    const int tid = tid_, lane = tid & 63, r32 = lane & 31, hi = lane >> 5;
    const int wid = __builtin_amdgcn_readfirstlane(tid >> 6);
    const int map = DIFF ? (wid >> 2) : 0, wq = DIFF ? (wid & 3) : wid;
    const int row = q0 + 32 * wq + r32;
    const int tlim = DIFF ? ((q0 + 32 * wq) >> 6) : (ntiles - 1);
    u32x4 stg[NLD], stg1[NLD];
    { const u32x4* g0 = (const u32x4*)img + tid;
#pragma unroll
      for (int k = 0; k < NLD; ++k) stg[k] = g0[k * 512];
      if (ntiles > 1) {
#pragma unroll
          for (int k = 0; k < NLD; ++k) stg1[k] = g0[IMG / 16 + k * 512]; } }
    bf16x8 qf[4];
    {
        const bf16_t* qrow = Qp + (size_t)row * qld + map * 384 + hi * 8;
        float qv[4][8]; float ss = 0.f;
#pragma unroll
        for (int d0 = 0; d0 < 4; ++d0) { const u32x4 w = *(const u32x4*)(qrow + 16 * d0);
            qv[d0][0] = bf_lo(w.x); qv[d0][1] = bf_hi(w.x); qv[d0][2] = bf_lo(w.y); qv[d0][3] = bf_hi(w.y);
            qv[d0][4] = bf_lo(w.z); qv[d0][5] = bf_hi(w.z); qv[d0][6] = bf_lo(w.w); qv[d0][7] = bf_hi(w.w); }
#pragma unroll
        for (int d0 = 0; d0 < 4; ++d0)
#pragma unroll
            for (int i = 0; i < 8; ++i) ss += qv[d0][i] * qv[d0][i];
        ss += __shfl_xor(ss, 32);
        const float rstd = rsqrtf(ss * (1.0f / 64.0f) + 1e-6f);
#pragma unroll
        for (int d0 = 0; d0 < 4; ++d0) { const f32x4 g0 = *(const f32x4*)(qg + 16 * d0 + 8 * hi), g1 = *(const f32x4*)(qg + 16 * d0 + 8 * hi + 4);
#pragma unroll
            for (int i = 0; i < 4; ++i) { qv[d0][i] *= rstd * g0[i]; qv[d0][4 + i] *= rstd * g1[i]; } }
        if (DIFF) {
#pragma unroll
            for (int i = 0; i < 8; ++i) { float c, s; rope_cs(row, i, c, s); const float p = __shfl_xor(qv[0][i], 32);
                qv[0][i] = hi == 0 ? (qv[0][i] * c - p * s) : (p * s + qv[0][i] * c); }
        }
        const float QS = 0.125f * 1.4426950408889634f;
#pragma unroll
        for (int d0 = 0; d0 < 4; ++d0) { u32x4 w; w.x = cvt_pk_bf16(qv[d0][0] * QS, qv[d0][1] * QS); w.y = cvt_pk_bf16(qv[d0][2] * QS, qv[d0][3] * QS);
            w.z = cvt_pk_bf16(qv[d0][4] * QS, qv[d0][5] * QS); w.w = cvt_pk_bf16(qv[d0][6] * QS, qv[d0][7] * QS); qf[d0] = __builtin_bit_cast(bf16x8, w); }
    }
#pragma unroll
    for (int k = 0; k < NLD; ++k) *(LAS u32x4*)(lds + (size_t)(tid + 512 * k) * 16) = stg[k];
    if (ntiles > 1) {
#pragma unroll
        for (int k = 0; k < NLD; ++k) *(LAS u32x4*)(lds + IMG + (size_t)(tid + 512 * k) * 16) = stg1[k]; }
    __syncthreads();
    f32x16 o[NDB];
#pragma unroll
    for (int db = 0; db < NDB; ++db)
#pragma unroll
        for (int r = 0; r < 16; ++r) o[db][r] = 0.f;
    float lsum = 0.f;
    const f32x16 negv = {0.f, 0.f, 0.f, 0.f, 0.f, 0.f, 0.f, 0.f, 0.f, 0.f, 0.f, 0.f, 0.f, 0.f, 0.f, 0.f}; (void)negM;
    f32x16 s0, s1; bf16x8 pw[4];
    constexpr int NPV = NDB * 4, EPM = 32 / NPV;
    const int koff = map * 8192 + hi * 1024 + r32 * 16, voff = VOFF + hi * VCH + r32 * 16;
#define ATT_KLD(kf_, bufp) do { const LAS unsigned char* kb_ = (bufp) + koff; \
        _Pragma("unroll") for (int d0 = 0; d0 < 4; ++d0) { kf_[2 * d0] = *(const LAS bf16x8*)(kb_ + d0 * 2048); kf_[2 * d0 + 1] = *(const LAS bf16x8*)(kb_ + d0 * 2048 + 512); } } while (0)
#define ATT_QKM(kf_) do { \
        s0 = __builtin_amdgcn_mfma_f32_32x32x16_bf16(kf_[0], qf[0], negv, 0, 0, 0); s1 = __builtin_amdgcn_mfma_f32_32x32x16_bf16(kf_[1], qf[0], negv, 0, 0, 0); \
        _Pragma("unroll") for (int d0 = 1; d0 < 4; ++d0) { s0 = __builtin_amdgcn_mfma_f32_32x32x16_bf16(kf_[2 * d0], qf[d0], s0, 0, 0, 0); s1 = __builtin_amdgcn_mfma_f32_32x32x16_bf16(kf_[2 * d0 + 1], qf[d0], s1, 0, 0, 0); } } while (0)
#define ATT_SUMPACK() do { float a0_ = 0.f, a1_ = 0.f; \
        _Pragma("unroll") for (int r = 0; r < 16; ++r) { a0_ += s0[r]; a1_ += s1[r]; } \
        lsum += a0_ + a1_; u32x4 w_; \
        w_.x = cvt_pk_bf16(s0[0], s0[1]); w_.y = cvt_pk_bf16(s0[2], s0[3]); w_.z = cvt_pk_bf16(s0[4], s0[5]); w_.w = cvt_pk_bf16(s0[6], s0[7]); pw[0] = __builtin_bit_cast(bf16x8, w_); \
        w_.x = cvt_pk_bf16(s0[8], s0[9]); w_.y = cvt_pk_bf16(s0[10], s0[11]); w_.z = cvt_pk_bf16(s0[12], s0[13]); w_.w = cvt_pk_bf16(s0[14], s0[15]); pw[1] = __builtin_bit_cast(bf16x8, w_); \
        w_.x = cvt_pk_bf16(s1[0], s1[1]); w_.y = cvt_pk_bf16(s1[2], s1[3]); w_.z = cvt_pk_bf16(s1[4], s1[5]); w_.w = cvt_pk_bf16(s1[6], s1[7]); pw[2] = __builtin_bit_cast(bf16x8, w_); \
        w_.x = cvt_pk_bf16(s1[8], s1[9]); w_.y = cvt_pk_bf16(s1[10], s1[11]); w_.z = cvt_pk_bf16(s1[12], s1[13]); w_.w = cvt_pk_bf16(s1[14], s1[15]); pw[3] = __builtin_bit_cast(bf16x8, w_); } while (0)
#define ATT_VLD(vbp, i) (*(const LAS bf16x8*)((vbp) + (2 * ((i) / NDB)) * VCH + ((i) % NDB) * 512))
    { bf16x8 kf[8]; ATT_KLD(kf, lds); ATT_QKM(kf); }
#pragma unroll
    for (int r = 0; r < 16; ++r) { s0[r] = __builtin_amdgcn_exp2f(s0[r]); s1[r] = __builtin_amdgcn_exp2f(s1[r]); }
    int offV = 0, offK = IMG, offS = 2 * IMG;
    const unsigned ldsbase = (unsigned)(uintptr_t)lds;
    if (wid >= 4) __builtin_amdgcn_s_setprio(1);
    constexpr int LA = 4;
#pragma unroll 1
    for (int t = 0; t < ntiles; ++t) {
        const bool more2 = (t + 2 < ntiles);
        const LAS unsigned char* vb = lds + offV + voff;
        if (t < tlim) {
            bf16x8 kf[8];
            ATT_KLD(kf, lds + offK);
            if (more2) { const unsigned char* g = img + (size_t)(t + 2) * IMG + wid * 1024 + lane * 16;
#pragma unroll
                for (int k = 0; k < NLD; ++k) glds16(g + k * 8192, (unsigned)__builtin_amdgcn_readfirstlane((int)(ldsbase + offS + wid * 1024 + k * 8192))); }
            __builtin_amdgcn_sched_barrier(0);
            ATT_SUMPACK();
            __builtin_amdgcn_sched_barrier(0);
            ATT_QKM(kf);
            bf16x8 vfr[4];
#pragma unroll
            for (int i = 0; i < LA; ++i) vfr[i] = ATT_VLD(vb, i);
            __builtin_amdgcn_sched_barrier(0);
#pragma unroll
            for (int i = 0; i < NPV; ++i) {
                o[i % NDB] = __builtin_amdgcn_mfma_f32_32x32x16_bf16(vfr[i & 3], pw[i / NDB], o[i % NDB], 0, 0, 0);
                if (i + LA < NPV) vfr[i & 3] = ATT_VLD(vb, i + LA);
#pragma unroll
                for (int e = 0; e < EPM; ++e) { const int k = i * EPM + e; if (k < 16) s0[k] = __builtin_amdgcn_exp2f(s0[k]); else s1[k - 16] = __builtin_amdgcn_exp2f(s1[k - 16]); }
                __builtin_amdgcn_sched_barrier(0);
            }
        } else {
            if (more2) { const unsigned char* g = img + (size_t)(t + 2) * IMG + wid * 1024 + lane * 16;
#pragma unroll
                for (int k = 0; k < NLD; ++k) glds16(g + k * 8192, (unsigned)__builtin_amdgcn_readfirstlane((int)(ldsbase + offS + wid * 1024 + k * 8192))); }
            if (t == tlim) {
                ATT_SUMPACK();
#pragma unroll
                for (int i = 0; i < NPV; ++i) { const bf16x8 vf = ATT_VLD(vb, i); o[i % NDB] = __builtin_amdgcn_mfma_f32_32x32x16_bf16(vf, pw[i / NDB], o[i % NDB], 0, 0, 0); }
            }
        }
        asm volatile("s_waitcnt vmcnt(0)" ::: "memory");
        __syncthreads();
        { const int tmp = offV; offV = offK; offK = offS; offS = tmp; }
    }
    __builtin_amdgcn_s_setprio(0);
#undef ATT_KLD
#undef ATT_QKM
#undef ATT_SUMPACK
#undef ATT_VLD
    const float l = lsum + __shfl_xor(lsum, 32);
    const float inv = 1.0f / l;
    if (DIFF) {
        LAS float* ex = (LAS float*)lds;
        if (map == 1) {
#pragma unroll
            for (int db = 0; db < NDB; ++db)
#pragma unroll
                for (int r = 0; r < 16; ++r) ex[((wq * NDB + db) * 16 + r) * 64 + lane] = o[db][r] * inv;
        }
        __syncthreads();
        if (map == 0) {
            float ss = 0.f;
#pragma unroll
            for (int db = 0; db < NDB; ++db)
#pragma unroll
                for (int r = 0; r < 16; ++r) { const float v = o[db][r] * inv - lam * ex[((wq * NDB + db) * 16 + r) * 64 + lane]; o[db][r] = v; ss += v * v; }
            ss += __shfl_xor(ss, 32);
            const float rs = rsqrtf(ss * (1.0f / 128.0f) + 1e-5f) * oscale;
            bf16_t* orow = Op + (size_t)row * old + 4 * hi;
#pragma unroll
            for (int db = 0; db < NDB; ++db)
#pragma unroll
                for (int rq = 0; rq < 4; ++rq) { const int d = 32 * db + 8 * rq; const f32x4 g = *(const f32x4*)(subg + d + 4 * hi);
                    u32x2 w; w.x = cvt_pk_bf16(o[db][4 * rq + 0] * rs * g[0], o[db][4 * rq + 1] * rs * g[1]); w.y = cvt_pk_bf16(o[db][4 * rq + 2] * rs * g[2], o[db][4 * rq + 3] * rs * g[3]);
                    st8_wt(orow + d, w); }
        }
        __syncthreads();
    } else {
        bf16_t* orow = Op + (size_t)row * old + 4 * hi;
#pragma unroll
        for (int db = 0; db < NDB; ++db)
#pragma unroll
            for (int rq = 0; rq < 4; ++rq) { const int d = 32 * db + 8 * rq;
                u32x2 w; w.x = cvt_pk_bf16(o[db][4 * rq + 0] * inv, o[db][4 * rq + 1] * inv); w.y = cvt_pk_bf16(o[db][4 * rq + 2] * inv, o[db][4 * rq + 3] * inv);
                st8_wt(orow + d, w); }
    }
}

__device__ const unsigned short kAttnSched[768] = {126, 39, 25, 109, 42, 40, 92, 55, 43, 115, 167, 37, 237, 44, 165, 127, 47, 16, 255, 51, 13, 93, 179, 175, 104, 46, 41, 122, 170, 27, 123, 63, 5, 121, 169, 29, 102, 48, 168, 112, 296, 295, 105, 45, 297, 99, 174, 173, 249, 69, 0, 119, 293, 34, 383, 302, 17, 377, 298, 28, 90, 307, 49, 89, 57, 301, 124, 177, 18, 120, 58, 141, 107, 430, 38, 511, 171, 21, 83, 54, 182, 111, 425, 423, 252, 185, 10, 114, 53, 24, 211, 313, 50, 248, 191, 7, 85, 56, 305, 101, 183, 35, 380, 59, 135, 125, 60, 6, 254, 176, 145, 118, 424, 33, 253, 299, 23, 339, 73, 163, 250, 291, 162, 117, 303, 155, 246, 166, 419, 116, 172, 30, 376, 421, 161, 378, 184, 269, 505, 186, 12, 382, 304, 144, 508, 547, 31, 633, 178, 19, 239, 427, 549, 103, 181, 290, 247, 52, 20, 375, 552, 32, 374, 680, 289, 98, 435, 426, 86, 309, 180, 232, 308, 418, 504, 311, 272, 245, 306, 152, 373, 555, 159, 242, 300, 160, 100, 314, 288, 501, 554, 416, 629, 429, 157, 110, 434, 287, 244, 558, 156, 372, 683, 415, 77, 188, 310, 500, 557, 158, 370, 431, 286, 113, 432, 414, 243, 686, 542, 106, 436, 417, 498, 562, 283, 233, 312, 670, 632, 442, 397, 628, 553, 546, 503, 437, 146, 87, 564, 563, 230, 441, 544, 228, 316, 543, 371, 438, 22, 502, 428, 285, 499, 559, 284, 251, 440, 140, 241, 433, 413, 235, 439, 541, 379, 187, 8, 626, 690, 411, 627, 561, 539, 76, 68, 687, 221, 197, 412, 231, 570, 669, 240, 566, 153, 369, 565, 280, 367, 694, 26, 495, 568, 408, 365, 569, 536, 756, 315, 15, 623, 567, 281, 630, 560, 409, 214, 443, 685, 757, 688, 154, 238, 693, 667, 360, 444, 282, 497, 66, 11, 366, 695, 410, 381, 62, 3, 636, 697, 9, 488, 61, 538, 493, 189, 149, 639, 317, 131, 108, 572, 151, 234, 445, 279, 494, 190, 274, 621, 571, 407, 236, 698, 664, 364, 573, 150, 622, 701, 147, 362, 318, 278, 220, 446, 677, 368, 201, 134, 78, 204, 36, 625, 319, 14, 363, 447, 277, 348, 575, 164, 95, 703, 545, 490, 64, 405, 631, 574, 138, 618, 192, 148, 746, 320, 533, 361, 194, 276, 358, 196, 404, 359, 67, 532, 487, 65, 535, 491, 322, 402, 507, 193, 2, 492, 448, 275, 635, 321, 259, 215, 450, 294, 75, 578, 689, 486, 70, 530, 763, 576, 4, 749, 449, 273, 226, 81, 139, 620, 195, 400, 217, 323, 675, 614, 451, 406, 354, 72, 660, 229, 325, 661, 509, 577, 1, 616, 198, 401, 751, 324, 268, 742, 200, 528, 637, 692, 525, 82, 328, 292, 80, 452, 682, 97, 453, 537, 482, 84, 136, 760, 579, 387, 349, 210, 143, 767, 704, 128, 750, 581, 267, 94, 208, 529, 356, 203, 271, 758, 326, 515, 484, 332, 142, 227, 205, 270, 615, 329, 398, 467, 71, 420, 743, 457, 526, 610, 79, 653, 355, 74, 657, 223, 454, 665, 759, 582, 130, 331, 199, 556, 342, 456, 672, 755, 327, 133, 225, 584, 534, 353, 338, 396, 765, 691, 654, 510, 705, 256, 351, 712, 663, 222, 209, 399, 481, 202, 403, 96, 696, 422, 224, 470, 264, 476, 91, 263, 489, 330, 395, 638, 699, 261, 609, 337, 524, 619, 458, 266, 479, 460, 531, 477, 343, 394, 213, 459, 671, 357, 336, 137, 738, 588, 656, 219, 218, 265, 347, 346, 393, 206, 716, 548, 587, 586, 681, 612, 465, 521, 605, 345, 392, 471, 455, 673, 352, 341, 649, 740, 466, 520, 474, 602, 522, 350, 333, 659, 496, 461, 258, 753, 710, 391, 748, 589, 389, 747, 334, 517, 207, 462, 674, 733, 475, 262, 478, 603, 390, 590, 717, 676, 764, 700, 519, 606, 88, 648, 335, 585, 550, 761, 580, 129, 624, 718, 257, 473, 598, 527, 480, 216, 518, 483, 464, 523, 344, 715, 540, 734, 604, 132, 730, 601, 652, 593, 706, 684, 485, 469, 260, 592, 583, 551, 607, 731, 388, 506, 709, 384, 732, 599, 651, 617, 721, 516, 463, 713, 679, 634, 707, 386, 726, 594, 662, 762, 708, 385, 737, 595, 650, 722, 711, 678, 212, 720, 666, 754, 714, 514, 744, 340, 642, 608, 729, 645, 745, 468, 513, 723, 591, 668, 611, 597, 646, 613, 472, 641, 741, 725, 644, 739, 596, 647, 752, 719, 512, 736, 735, 640, 766, 702, 643, 600, 724, 658, 728, 727, 655};

__device__ __forceinline__ float max_abs64(const float* g) { float m = 0.f; for (int i = 0; i < 64; ++i) m = fmaxf(m, fabsf(g[i])); return m; }

#define XB_TMO      128
#define XB_XCNT(j)  (256  + 64 * (j))
#define XB_XSUB(j)  (1280 + 64 * (j))
#define XB_XGEN(j)  (2304 + 64 * (j))
#define XB_TOP      3328
#define XB_TOPGEN   3392
#define XCD_BAR_WORDS 3456
#define XB_SPIN_CAP (1u << 18)

__device__ __forceinline__ unsigned xb_ld(unsigned* p)              { return __hip_atomic_load(p, __ATOMIC_RELAXED, __HIP_MEMORY_SCOPE_AGENT); }
__device__ __forceinline__ unsigned xb_add(unsigned* p, unsigned v) { return __hip_atomic_fetch_add(p, v, __ATOMIC_RELAXED, __HIP_MEMORY_SCOPE_AGENT); }
__device__ __forceinline__ unsigned xb_xcc_id() { return (unsigned)__builtin_amdgcn_s_getreg((3 << 11) | 20) & 0xFu; }
#define XB_SPIN(cond, bar) do { unsigned _sp = 0; while (cond) { __builtin_amdgcn_s_sleep(1); \
    if ((++_sp & 255u) == 0u) { if (xb_ld(&(bar)[XB_TMO])) break; if (_sp > XB_SPIN_CAP) { atomicAdd(&(bar)[XB_TMO], 1u); break; } } } } while (0)

struct XcdBarrier {
    unsigned* bar; unsigned x;
    volatile LAS unsigned* st;
};

__device__ __forceinline__ XcdBarrier xcd_barrier_post(unsigned* bar, volatile LAS unsigned* st) {
    XcdBarrier b; b.bar = bar; b.x = xb_xcc_id(); b.st = st;
    if (threadIdx.x == 0) (void)xb_add(&bar[XB_XCNT(b.x)], 1u);
    return b;
}
__device__ __forceinline__ void xcd_barrier_complete(unsigned* bar, unsigned x, unsigned& nloc, unsigned& nx) {
    const unsigned G = gridDim.x * gridDim.y * gridDim.z;
    unsigned sum, cnt, mine, sp = 0u;
    for (;;) {
        sum = 0u; cnt = 0u; mine = 0u;
#pragma unroll
        for (unsigned j = 0; j < 16; ++j) { const unsigned c = xb_ld(&bar[XB_XCNT(j)]); sum += c; cnt += (c > 0u) ? 1u : 0u; mine = (j == x) ? c : mine; }
        if (sum == G) break;
        __builtin_amdgcn_s_sleep(1);
        if ((++sp & 255u) == 0u) { if (xb_ld(&bar[XB_TMO])) break; if (sp > XB_SPIN_CAP) { atomicAdd(&bar[XB_TMO], 1u); break; } }
    }
    nloc = mine > 0u ? mine : 1u; nx = cnt > 0u ? cnt : 1u;
}

__device__ __forceinline__ void xcd_barrier(const XcdBarrier& b) {
    asm volatile("s_waitcnt vmcnt(0)" ::: "memory");
    __syncthreads();
    if (threadIdx.x == 0) {
        unsigned* bar = b.bar;
        __builtin_amdgcn_s_waitcnt(0);
        unsigned nloc = b.st[0], nx = b.st[1];
        if (nloc == 0u) { xcd_barrier_complete(bar, b.x, nloc, nx); b.st[0] = nloc; b.st[1] = nx; }
        const unsigned old = xb_add(&bar[XB_XSUB(b.x)], 1u);
        const unsigned gen = old / nloc;
        if (old + 1u == (gen + 1u) * nloc) {
            __builtin_amdgcn_fence(__ATOMIC_RELEASE, "agent");
            asm volatile("s_waitcnt vmcnt(0)" ::: "memory");
            const unsigned og = xb_add(&bar[XB_TOP], 1u);
            const unsigned tg = og / nx;
            if (og + 1u == (tg + 1u) * nx) xb_add(&bar[XB_TOPGEN], 1u);
            else XB_SPIN(xb_ld(&bar[XB_TOPGEN]) == tg, bar);
            __builtin_amdgcn_fence(__ATOMIC_ACQUIRE, "agent");
            xb_add(&bar[XB_XGEN(b.x)], 1u);
            asm volatile("s_waitcnt vmcnt(0)" ::: "memory");
        } else {
            XB_SPIN(xb_ld(&bar[XB_XGEN(b.x)]) == gen, bar);
            __builtin_amdgcn_fence(__ATOMIC_ACQUIRE, "agent");
            asm volatile("s_waitcnt vmcnt(0)" ::: "memory");
        }
    }
    __syncthreads();
}

__device__ __forceinline__ int panel_rstd_to_lds(LAS unsigned char* lds, const float* stats, const pg8::StaticOrder& S) {
    pg8::Unit u0; const bool has = S.next(0, u0);
    LAS float* rl = (LAS float*)(lds + MISC_OFF + 1024);
    if (has && threadIdx.x < 256) rl[threadIdx.x] = row_rstd(stats, u0.pm * 256 + (int)threadIdx.x);
    __syncthreads();
    return has ? u0.pm : -1;
}

__device__ __forceinline__ void prologue_body(const Args& a, LAS unsigned char* lds) {
    int tid_ = threadIdx.x; asm volatile("" : "+v"(tid_)); const int tid = tid_, lane = tid & 63, wave = __builtin_amdgcn_readfirstlane(tid >> 6);
    const int G = gridDim.x, bx = blockIdx.x;
    const int gw = bx * NWAVES + wave, NGW = G * NWAVES;
    unsigned char* ws = a.ws;
    float* stats = (float*)(ws + WS_STATS);
    unsigned char* memimg = ws + WS_MEMIMG;
    bf16_t* WinA = (bf16_t*)(ws + WS_WINA); bf16_t* Wqkv = (bf16_t*)(ws + WS_WQKV); bf16_t* Wq1 = (bf16_t*)(ws + WS_WQ1); bf16_t* Wmkv = (bf16_t*)(ws + WS_WMKV);
    bf16_t* Wo = (bf16_t*)(ws + WS_WO); bf16_t* Wup = (bf16_t*)(ws + WS_WUP); bf16_t* Wdn = (bf16_t*)(ws + WS_WDN);
    bf16_t* XB = (bf16_t*)(ws + WS_XB); unsigned char* kvimg = ws + WS_KVIMG; bf16_t* H = (bf16_t*)(ws + WS_H);
    bf16_t* U = (bf16_t*)(ws + WS_U); bf16_t* QB = (bf16_t*)(ws + WS_QB); bf16_t* CAT = (bf16_t*)(ws + WS_CAT); bf16_t* KVB = (bf16_t*)(ws + WS_KVB);
    bf16_t* MEMN = (bf16_t*)(ws + WS_MEMN); bf16_t* MKV = (bf16_t*)(ws + WS_MKV);
    unsigned* ctl = (unsigned*)(ws + WS_CTL);
    LAS float* scr = (LAS float*)(lds + wave * 16384);
    LAS unsigned* misc = (LAS unsigned*)(lds + MISC_OFF);

    {
        int base = 0; const bool defer = (G == 256);
        for (int l = 0; l < (defer ? 1 : 2); ++l)
            convert_job<1>(base, gw, NGW, a.a_w_in + (size_t)l * 1024 * 2560, 1024, 2560, 2560, a.norm_mix + l * 1024, WinA + (size_t)l * 2560 * 1024, 0, 0, scr, lane);
        if (!defer) {
            convert_job<0>(base, gw, NGW, a.b_w_q, 1024, 1024, 1024, a.norm_mix + 2 * 1024, Wqkv, 0, 0, scr, lane);
            convert_job<0>(base, gw, NGW, a.w_kv, 1024, 1536, 1536, a.kv_norm, Wqkv, 1024, 0, scr, lane);
            convert_job<0>(base, gw, NGW, a.b_w_q + (size_t)1024 * 1024, 1024, 1024, 1024, a.norm_mix + 3 * 1024, Wq1, 0, 0, scr, lane);
        }
        for (int l = 0; l < 4; ++l) {
            convert_job<0>(base, gw, NGW, a.w_mem_kv + (size_t)l * 1024 * 512, 1024, 512, 512, nullptr, Wmkv, l * 512, 0, scr, lane);
            if (l == 0 || !defer) convert_job<0>(base, gw, NGW, a.w_o + (size_t)l * 1024 * 1024, 1024, 1024, 1024, nullptr, Wo + (size_t)l * 1024 * 1024, 0, 0, scr, lane);
        }
        for (int m0 = gw; m0 < S_; m0 += 4 * NGW) {
            f32x4 v[4][4];
#pragma unroll
            for (int q = 0; q < 4; ++q) { const int m = m0 + q * NGW; if (m < S_) { const f32x4* xr = (const f32x4*)(a.x + (size_t)m * 1024) + lane;
#pragma unroll
                for (int j = 0; j < 4; ++j) v[q][j] = __builtin_nontemporal_load(xr + 64 * j); } }
#pragma unroll
            for (int q = 0; q < 4; ++q) { const int m = m0 + q * NGW; if (m < S_) { float s = 0.f;
#pragma unroll
                for (int j = 0; j < 4; ++j) s += (v[q][j][0] * v[q][j][0] + v[q][j][1] * v[q][j][1]) + (v[q][j][2] * v[q][j][2] + v[q][j][3] * v[q][j][3]);
                s = wave_sum(s);
                u32x2* o8 = (u32x2*)(XB + (size_t)m * 1024) + lane;
#pragma unroll
                for (int j = 0; j < 4; ++j) { u32x2 w; w.x = cvt_pk_bf16(v[q][j][0], v[q][j][1]); w.y = cvt_pk_bf16(v[q][j][2], v[q][j][3]); o8[64 * j] = w; }
                if (lane < 16) stats[(size_t)m * 16 + lane] = lane == 0 ? s : 0.f; } }
        }
        for (int m = gw; m < MEMLEN; m += NGW) {
            const f32x4* xr = (const f32x4*)(a.mem + (size_t)m * 1024) + lane; const f32x4* gr = (const f32x4*)a.mem_norm + lane; f32x4 v[4]; float s = 0.f;
#pragma unroll
            for (int j = 0; j < 4; ++j) { v[j] = xr[64 * j]; s += (v[j][0] * v[j][0] + v[j][1] * v[j][1]) + (v[j][2] * v[j][2] + v[j][3] * v[j][3]); }
            s = wave_sum(s); const float rstd = rsqrtf(s * (1.0f / 1024.0f) + 1e-6f);
            u32x2* o8 = (u32x2*)(MEMN + (size_t)m * 1024) + lane;
#pragma unroll
            for (int j = 0; j < 4; ++j) { const f32x4 g = gr[64 * j]; u32x2 w; w.x = cvt_pk_bf16(v[j][0] * rstd * g[0], v[j][1] * rstd * g[1]); w.y = cvt_pk_bf16(v[j][2] * rstd * g[2], v[j][3] * rstd * g[3]); o8[64 * j] = w; }
        }
    }
}

template <int l>
__device__ __forceinline__ void layer_body(const Args& a, LAS unsigned char* lds, const XcdBarrier& bar) {
    int tid_ = threadIdx.x; asm volatile("" : "+v"(tid_)); const int tid = tid_, lane = tid & 63, wave = __builtin_amdgcn_readfirstlane(tid >> 6);
    const int G = gridDim.x, bx = blockIdx.x;
    const int gw = bx * NWAVES + wave, NGW = G * NWAVES;
    unsigned char* ws = a.ws;
    float* stats = (float*)(ws + WS_STATS);
    unsigned char* memimg = ws + WS_MEMIMG;
    bf16_t* WinA = (bf16_t*)(ws + WS_WINA); bf16_t* Wqkv = (bf16_t*)(ws + WS_WQKV); bf16_t* Wq1 = (bf16_t*)(ws + WS_WQ1); bf16_t* Wmkv = (bf16_t*)(ws + WS_WMKV);
    bf16_t* Wo = (bf16_t*)(ws + WS_WO); bf16_t* Wup = (bf16_t*)(ws + WS_WUP); bf16_t* Wdn = (bf16_t*)(ws + WS_WDN);
    bf16_t* XB = (bf16_t*)(ws + WS_XB); unsigned char* kvimg = ws + WS_KVIMG; bf16_t* H = (bf16_t*)(ws + WS_H);
    bf16_t* U = (bf16_t*)(ws + WS_U); bf16_t* QB = (bf16_t*)(ws + WS_QB); bf16_t* CAT = (bf16_t*)(ws + WS_CAT); bf16_t* KVB = (bf16_t*)(ws + WS_KVB);
    bf16_t* MEMN = (bf16_t*)(ws + WS_MEMN); bf16_t* MKV = (bf16_t*)(ws + WS_MKV);
    unsigned* ctl = (unsigned*)(ws + WS_CTL);
    LAS float* scr = (LAS float*)(lds + wave * 16384);
    LAS unsigned* misc = (LAS unsigned*)(lds + MISC_OFF);

    const float LOG2E = 1.4426950408889634f;
    {
        const bool isA = l < 2; const int j = l - 2;
        if (isA) {
            pg8::Gemm g{XB, WinA + (size_t)l * 2560 * 1024, S_, 2560, 1024}; pg8::StaticOrder S; S.init(S_, 2560, G, bx);
            const int pm0 = panel_rstd_to_lds(lds, stats, S);
            EpiInA E{stats, U, CAT, (const LAS float*)(lds + MISC_OFF + 1024), pm0};
            pg8::gemm_phase<EpiInA, pg8::StaticOrder, true, true>(lds, g, S, E);
            if (l == 0) {
                pg8::Gemm g2{MEMN, Wmkv, MEMLEN, 2048, 1024}; pg8::StaticOrder S2; S2.init(MEMLEN, 2048, G, (bx + 8) % G);
                EpiBf16<0> E2{nullptr, 1 << 30, MKV, 2048, MKV, 2048, nullptr, -1};
                pg8::gemm_phase<EpiBf16<0>, pg8::StaticOrder, true, true>(lds, g2, S2, E2);
            }
        } else {
            const int N = (j == 0) ? 2560 : 1024;
            pg8::Gemm g{XB, j == 0 ? Wqkv : Wq1, S_, N, 1024}; pg8::StaticOrder S; S.init(S_, N, G, bx);
            const int pm0 = panel_rstd_to_lds(lds, stats, S);
            EpiBf16<0> E{stats, 1024, QB, 1024, KVB, 1536, (const LAS float*)(lds + MISC_OFF + 1024), pm0};
            pg8::gemm_phase<EpiBf16<0>, pg8::StaticOrder, true, true>(lds, g, S, E);
        }
        {
            const bool half = (l < 3) && (G == 256);
            const int nconv = (l == 0) ? 120 : 128;
            if (!half || (bx >= 128 && bx < 128 + nconv)) {
                int base = 0; const int gw2 = half ? gw - 128 * NWAVES : gw, NGW2 = half ? nconv * NWAVES : NGW;
                if (l < 3) {
                    convert_job<0>(base, gw2, NGW2, a.w_up + (size_t)l * 1024 * 4096, 1024, 4096, 4096, a.norm_mlp + l * 1024, Wup, 0, 0, scr, lane);
                    convert_job<0>(base, gw2, NGW2, a.w_down + (size_t)l * 4096 * 1024, 4096, 1024, 1024, nullptr, Wdn, 0, 0, scr, lane);
                }
                if (half) {
                    if (l == 0) convert_job<1>(base, gw2, NGW2, a.a_w_in + (size_t)1024 * 2560, 1024, 2560, 2560, a.norm_mix + 1024, WinA + (size_t)2560 * 1024, 0, 0, scr, lane);
                    if (l == 1) { convert_job<0>(base, gw2, NGW2, a.b_w_q, 1024, 1024, 1024, a.norm_mix + 2 * 1024, Wqkv, 0, 0, scr, lane);
                                  convert_job<0>(base, gw2, NGW2, a.w_kv, 1024, 1536, 1536, a.kv_norm, Wqkv, 1024, 0, scr, lane); }
                    if (l == 2) convert_job<0>(base, gw2, NGW2, a.b_w_q + (size_t)1024 * 1024, 1024, 1024, 1024, a.norm_mix + 3 * 1024, Wq1, 0, 0, scr, lane);
                    convert_job<0>(base, gw2, NGW2, a.w_o + (size_t)(l + 1) * 1024 * 1024, 1024, 1024, 1024, nullptr, Wo + (size_t)(l + 1) * 1024 * 1024, 0, 0, scr, lane);
                }
                if ((l == 1 && half) || (l == 3 && !(G == 256)))
                    convert_job<0>(base, gw2, NGW2, a.w_up + (size_t)3 * 1024 * 4096, 1024, 4096, 4096, a.norm_mlp + 3 * 1024, (bf16_t*)a.out, 0, 0, scr, lane);
                if ((l == 2 && half) || (l == 3 && !(G == 256)))
                    convert_job<0>(base, gw2, NGW2, a.w_down + (size_t)3 * 4096 * 1024, 4096, 1024, 1024, nullptr, WinA, 0, 0, scr, lane);
            }
        }
        xcd_barrier(bar);

        if (l == 0) {
            for (int it = gw; it < 64; it += NGW) { const int t = it & 3, h = (it >> 2) & 3, ly = it >> 4;
                kv_post_item<false, 64, 1>(MKV, 2048, ly * 512 + h * 64, 0, ly * 512 + 256 + h * 64, 64 * t, a.mem_k_norm + ly * 64, memimg + (size_t)((ly * 4 + h) * 4 + t) * 16384, lane); }
        }
        if (l == 2) {
            for (int it = gw; it < 6 * 256; it += NGW) { const int t = it & 255, h = it >> 8;
                kv_post_item<true, 128, 2>(KVB, 1536, h * 64, 384, 768 + h * 128, 64 * t, a.k_norm, kvimg + (size_t)(h * 256 + t) * 32768, lane); }
        }
        if (isA) {
            const float* wc = a.a_conv + (size_t)l * 3 * 768;
            for (int it = bx * 512 + tid; it < (S_ / 4) * 96; it += G * 512) {
                const int t0 = (it / 96) * 4, ch = (it % 96) * 8;
                u32x4 uu[6], bb[4];
#pragma unroll
                for (int r = 0; r < 6; ++r) { const int t = t0 - 2 + r; uu[r] = (u32x4){0u, 0u, 0u, 0u}; if (t >= 0) uu[r] = *(const u32x4*)(U + (size_t)t * 768 + ch); }
#pragma unroll
                for (int r = 0; r < 4; ++r) bb[r] = *(const u32x4*)(CAT + (size_t)(t0 + r) * 1024 + ch);
                const f32x4 w0a = *(const f32x4*)(wc + ch), w0b = *(const f32x4*)(wc + ch + 4), w1a = *(const f32x4*)(wc + 768 + ch), w1b = *(const f32x4*)(wc + 768 + ch + 4),
                            w2a = *(const f32x4*)(wc + 1536 + ch), w2b = *(const f32x4*)(wc + 1536 + ch + 4);
#define CONV2(k, bw, u0w, u1w, u2w, wa0, wa1, wa2, e) \
                y[k] = bf_lo(bw) * (wa0[e] * bf_lo(u0w) + wa1[e] * bf_lo(u1w) + wa2[e] * bf_lo(u2w)); \
                y[k + 1] = bf_hi(bw) * (wa0[e + 1] * bf_hi(u0w) + wa1[e + 1] * bf_hi(u1w) + wa2[e + 1] * bf_hi(u2w));
#pragma unroll
                for (int r = 0; r < 4; ++r) {
                    const u32x4 b = bb[r], u0 = uu[r], u1 = uu[r + 1], u2 = uu[r + 2]; float y[8];
                    CONV2(0, b.x, u0.x, u1.x, u2.x, w0a, w1a, w2a, 0) CONV2(2, b.y, u0.y, u1.y, u2.y, w0a, w1a, w2a, 2)
                    CONV2(4, b.z, u0.z, u1.z, u2.z, w0b, w1b, w2b, 0) CONV2(6, b.w, u0.w, u1.w, u2.w, w0b, w1b, w2b, 2)
                    u32x4 w; w.x = cvt_pk_bf16(y[0], y[1]); w.y = cvt_pk_bf16(y[2], y[3]); w.z = cvt_pk_bf16(y[4], y[5]); w.w = cvt_pk_bf16(y[6], y[7]);
                    *(u32x4*)(CAT + (size_t)(t0 + r) * 1024 + ch) = w;
                }
#undef CONV2
            }
        }
        if (l == 0 || l == 2) xcd_barrier(bar);

        {
            const float memM = 8.0f * max_abs64(a.mem_q_norm + l * 64) * max_abs64(a.mem_k_norm + l * 64) * LOG2E * 1.02f;
            const bf16_t* Qsrc = isA ? CAT : QB;
            if (isA) {
                for (int u = bx; u < 256; u += G) { const int qb = u >> 2, h = u & 3;
                    attn_unit<false>(lds, Qsrc + 768 + h * 64, 1024, a.mem_q_norm + l * 64, memimg + (size_t)((l * 4 + h) * 4) * 16384, 4, qb * 256, CAT + 768 + h * 64, 1024, -memM, 0.f, nullptr, 0.f); }
            } else {
                const float* lp = a.b_lam + j * 256; float d01 = 0.f, d23 = 0.f;
                for (int i = 0; i < 64; ++i) { d01 += lp[i] * lp[64 + i]; d23 += lp[128 + i] * lp[192 + i]; }
                const float lam_init = 0.8f - 0.6f * expf(-0.3f * (float)l);
                const float lam = expf(d01) - expf(d23) + lam_init;
                const float dM = 8.0f * max_abs64(a.b_q_norm + j * 64) * max_abs64(a.k_norm) * LOG2E * 1.02f;
                {
                unsigned* ctrs = ctl + j * 1280;
                for (;;) {
                    if (tid == 0) misc[0] = atomicAdd(ctrs, 1u);
                    __syncthreads();
                    const unsigned tk = misc[0];
                    __syncthreads();
                    if (tk >= 512u) break;
                    if (tk < 256u) { const unsigned jb = tk;
#pragma unroll 1
                        for (int k = 0; k < 3; ++k) { const int e = kAttnSched[jb * 3 + k], h = e >> 7, qblk = e & 127;
                            attn_unit<true>(lds, QB + h * 64, 1024, a.b_q_norm + j * 64, kvimg + (size_t)(h * 256) * 32768, 2 * qblk + 2, qblk * 128, CAT + h * 128, 1024, -dM, lam, a.b_subln + j * 128, 1.0f - lam_init); }
                    } else { const unsigned u = tk - 256u; const int qb = (int)(u >> 2), h = (int)(u & 3u);
                        attn_unit<false>(lds, Qsrc + 768 + h * 64, 1024, a.mem_q_norm + l * 64, memimg + (size_t)((l * 4 + h) * 4) * 16384, 4, qb * 256, CAT + 768 + h * 64, 1024, -memM, 0.f, nullptr, 0.f); }
                }
                }
            }
        }
        xcd_barrier(bar);

        {
            pg8::Gemm g{CAT, Wo + (size_t)l * 1024 * 1024, S_, 1024, 1024}; pg8::StaticOrder S; S.init(S_, 1024, G, bx);
            EpiRes E{nullptr, XB, stats};
            pg8::gemm_phase<EpiRes, pg8::StaticOrder, true, true>(lds, g, S, E);
        }
        xcd_barrier(bar);
        {
            pg8::Gemm g{XB, l == 3 ? (const bf16_t*)a.out : Wup, S_, 4096, 1024}; pg8::StaticOrder S; S.init(S_, 4096, G, bx);
            const int pm0 = panel_rstd_to_lds(lds, stats, S);
            EpiBf16<1> E{stats, 1 << 30, H, 4096, H, 4096, (const LAS float*)(lds + MISC_OFF + 1024), pm0};
            pg8::gemm_phase<EpiBf16<1>, pg8::StaticOrder, true, true>(lds, g, S, E);
        }
        xcd_barrier(bar);
        {
            pg8::Gemm g{H, l == 3 ? WinA : Wdn, S_, 1024, 4096}; pg8::StaticOrder S; S.init(S_, 1024, G, bx);
            EpiRes E{l == 3 ? a.out : nullptr, XB, stats};
            pg8::gemm_phase<EpiRes, pg8::StaticOrder, true, true>(lds, g, S, E);
        }
        if (l < 3) xcd_barrier(bar);
    }
}

__global__ void __launch_bounds__(NWAVES * 64, 2) yoco_fwd(Args a) {
    extern __shared__ __attribute__((aligned(16))) unsigned char lds_raw[];
    LAS unsigned char* lds = (LAS unsigned char*)lds_raw;
    cg::grid_group grid = cg::this_grid();
    { LAS unsigned* mz = (LAS unsigned*)(lds + MISC_OFF); if (threadIdx.x < 32) mz[threadIdx.x] = 0u; }
    __syncthreads();
    XcdBarrier bar = xcd_barrier_post((unsigned*)(a.ws + WS_CTL) + 4096, (volatile LAS unsigned*)(lds + MISC_OFF) + 8);
    prologue_body(a, lds);
    if (a.ws == nullptr) grid.sync();
    xcd_barrier(bar);
    layer_body<0>(a, lds, bar);
    layer_body<1>(a, lds, bar);
    layer_body<2>(a, lds, bar);
    layer_body<3>(a, lds, bar);
}

extern "C" void kernel_launch(void* const* d_in, const int* in_sizes, int n_in, void* d_out, int out_size, void* d_ws, size_t ws_size, hipStream_t stream) {
    static int grid = 0;
    if (grid == 0) {
        if (n_in != 20 || ws_size < WS_END) { fprintf(stderr, "kernel_launch: unexpected n_in %d / ws_size %zu\n", n_in, ws_size); grid = -1; return; }
        int dev = 0, cus = 0, per_cu = 0;
        hipGetDevice(&dev); hipDeviceGetAttribute(&cus, hipDeviceAttributeMultiprocessorCount, dev);
        hipFuncSetAttribute((const void*)yoco_fwd, hipFuncAttributeMaxDynamicSharedMemorySize, LDS_BYTES);
        hipOccupancyMaxActiveBlocksPerMultiprocessor(&per_cu, (const void*)yoco_fwd, NWAVES * 64, LDS_BYTES);
        (void)hipGetLastError();
        if (per_cu < 1) per_cu = 1;
        grid = cus;
        fprintf(stderr, "kernel_launch: cus %d per_cu %d grid %d\n", cus, per_cu, grid);
    }
    if (grid < 0) return;
    hipMemsetAsync((char*)d_ws + WS_CTL, 0, 65536, stream);
    Args a{};
    const float** pp = (const float**)&a;
    for (int i = 0; i < 20; ++i) pp[i] = (const float*)d_in[i];
    a.out = (float*)d_out; a.ws = (unsigned char*)d_ws;
    void* args[] = {&a};
    hipError_t e = hipLaunchCooperativeKernel((const void*)yoco_fwd, dim3(grid), dim3(NWAVES * 64), args, LDS_BYTES, stream);
    if (e != hipSuccess) fprintf(stderr, "cooperative launch failed: %s (grid %d)\n", hipGetErrorString(e), grid);
}
```
